# Optimizing an MI355X kernel written in HIP

```python
import jax, jax.numpy as jnp
from jax import lax
import numpy as np

D_MODEL = 1024
BATCH = 4
SEQ = 8192
DEPTH = 4

CHUNK = 64
HEAD_DIM = 64
RWKV_WIDTH = D_MODEL // 2
RWKV_HEADS = RWKV_WIDTH // HEAD_DIM
RWKV_LORA_W = 64
RWKV_LORA_A = 64
RWKV_LORA_G = 128
DSA_WIDTH = D_MODEL - RWKV_WIDTH
DSA_HEADS = DSA_WIDTH // HEAD_DIM
IDX_HEADS = 4
IDX_DIM = 64
INDEX_TOPK = 256
Q_BLOCK = 128
ROPE_THETA = 500000.0
ROPE_DIM = HEAD_DIM // 4
POOL_WINDOWS = (2, 4, 8, 16)
POOL_GROUPS = len(POOL_WINDOWS)
POOL_WIDTH = D_MODEL // 2
POOL_GROUP_DIM = POOL_WIDTH // POOL_GROUPS
SG_WIDTH = D_MODEL - POOL_WIDTH
SG_GROUPS = 4
SG_GROUP_DIM = SG_WIDTH // SG_GROUPS
SG_CHUNK = 128
D_FF = 2816
CONV_WIDTH = 3
N_EVEN = (DEPTH + 1) // 2
N_ODD = DEPTH // 2
ALPHA = (2.0 * DEPTH) ** 0.25
BETA = (8.0 * DEPTH) ** -0.25
LN_EPS = 1e-5
GN_EPS = 64e-5
NEG_INF = -1e30
RWKV_SPLITS = (RWKV_WIDTH, RWKV_WIDTH, RWKV_WIDTH, RWKV_LORA_W, RWKV_LORA_A, RWKV_LORA_G)
DSA_SPLITS = (DSA_WIDTH, DSA_WIDTH, DSA_WIDTH, IDX_HEADS * IDX_DIM, IDX_DIM, IDX_HEADS)
RWKV_COLS = sum(RWKV_SPLITS)
DSA_COLS = sum(DSA_SPLITS)
EVEN_COLS = RWKV_COLS + DSA_COLS
ODD_COLS = POOL_WIDTH + 2 * SG_WIDTH

kernel_name = 'hybrid_rwkv7_dsa_pool_sgmlp_trunk'


def _split(p, sizes):
    cuts = [int(s) for s in np.cumsum(sizes)[:-1]]
    return jnp.split(p, cuts, axis=-1)


def _layer_norm(x, g, b, eps=LN_EPS):
    xf = x.astype(jnp.float32)
    mu = xf.mean(-1, keepdims=True)
    var = jnp.square(xf - mu).mean(-1, keepdims=True)
    return ((xf - mu) * lax.rsqrt(var + eps)).astype(x.dtype) * g + b


def _shift_prev(x):
    return jnp.pad(x, ((0, 0), (1, 0), (0, 0)))[:, :-1]


def _rope_tables(seq_len):
    inv = ROPE_THETA ** (-jnp.arange(0, ROPE_DIM, 2, dtype=jnp.float32) / ROPE_DIM)
    ang = jnp.arange(seq_len, dtype=jnp.float32)[:, None] * inv[None, :]
    return jnp.cos(ang), jnp.sin(ang)


def _partial_rope(x, cos, sin):
    half = ROPE_DIM // 2
    c = cos[None, :, None, :].astype(x.dtype)
    s = sin[None, :, None, :].astype(x.dtype)
    x1, x2, xp = x[..., :half], x[..., half:ROPE_DIM], x[..., ROPE_DIM:]
    return jnp.concatenate([x1 * c - x2 * s, x1 * s + x2 * c, xp], axis=-1)


def _rwkv7_mix(p, mu, w0, w2, a0, a2, g2, k_k, k_a, r_k, gn_g, gn_b):
    bsz, seq, _ = p.shape
    dt = p.dtype
    f32 = jnp.float32
    p = p + (_shift_prev(p) - p) * mu
    r, k, v, wd, ad, gd = _split(p, RWKV_SPLITS)
    w_log = -jax.nn.softplus(-(w0 + jnp.tanh(wd) @ w2)) - 0.5
    decay = jnp.exp(-jnp.exp(w_log.astype(f32)))
    a = jax.nn.sigmoid(a0 + ad @ a2)
    g = jax.nn.sigmoid(gd) @ g2
    hd = lambda t: t.astype(f32).reshape(bsz, seq, RWKV_HEADS, HEAD_DIM)
    kk = hd(k * k_k)
    kk = kk / jnp.maximum(jnp.sqrt(jnp.sum(kk * kk, -1, keepdims=True)), 1e-12)
    k = k * (1 + (a - 1) * k_a)
    r_h, k_h, v_h, a_h, w_h = hd(r), hd(k), hd(v), hd(a), hd(decay)
    xs = tuple(jnp.moveaxis(t, 1, 0) for t in (r_h, w_h, k_h, v_h, kk, a_h))

    def step(S, inp):
        r_t, w_t, k_t, v_t, kk_t, a_t = inp
        sa = jnp.einsum('bhij,bhj->bhi', S, -kk_t)
        S = S * w_t[:, :, None, :] + sa[..., None] * (kk_t * a_t)[:, :, None, :] + v_t[..., None] * k_t[:, :, None, :]
        return S, jnp.einsum('bhij,bhj->bhi', S, r_t)

    S0 = jnp.zeros((bsz, RWKV_HEADS, HEAD_DIM, HEAD_DIM), f32)
    _, o = lax.scan(step, S0, xs)
    o = jnp.moveaxis(o, 0, 1)
    mean = o.mean(-1, keepdims=True)
    var = jnp.square(o - mean).mean(-1, keepdims=True)
    o = ((o - mean) * lax.rsqrt(var + GN_EPS)).reshape(bsz, seq, RWKV_WIDTH) * gn_g + gn_b
    bonus = (jnp.sum(r_h * k_h * r_k, -1, keepdims=True) * v_h).reshape(bsz, seq, RWKV_WIDTH)
    return ((o + bonus) * g).astype(dt)


def _dsa_mix(p, cos, sin, ik_g, ik_b):
    bsz, seq, _ = p.shape
    dt = p.dtype
    f32 = jnp.float32
    q, k, v, qi, ki, wi = _split(p, DSA_SPLITS)
    hd = lambda t: t.reshape(bsz, seq, DSA_HEADS, HEAD_DIM)
    q = _partial_rope(hd(q), cos, sin)
    k = _partial_rope(hd(k), cos, sin)
    v = hd(v)
    qi = _partial_rope(qi.reshape(bsz, seq, IDX_HEADS, IDX_DIM), cos, sin)
    ki = _partial_rope(_layer_norm(ki, ik_g, ik_b)[:, :, None, :], cos, sin)[:, :, 0, :]
    wi = wi * (IDX_HEADS ** -0.5 * IDX_DIM ** -0.5)
    topk = min(INDEX_TOPK, seq // 4)
    nb = seq // Q_BLOCK
    key_chunk = jnp.arange(seq) // CHUNK
    scale = HEAD_DIM ** -0.5
    ki32 = ki.astype(f32)

    def block(args):
        qb, qib, wib, start = args
        t_chunk = (start + jnp.arange(Q_BLOCK)) // CHUNK
        admissible = key_chunk[None, :] <= t_chunk[:, None]
        s = jax.nn.relu(jnp.einsum('bqhd,bsd->bqhs', qib.astype(f32), ki32))
        score = jnp.einsum('bqh,bqhs->bqs', wib.astype(f32), s)
        score = jnp.where(admissible[None], score, NEG_INF)
        _, idx = lax.top_k(score, topk)
        valid = (idx // CHUNK) <= t_chunk[None, :, None]
        k_sel = jax.vmap(lambda kb, ib: kb[ib])(k, idx)
        v_sel = jax.vmap(lambda vb, ib: vb[ib])(v, idx)
        logits = jnp.einsum('bqhd,bqkhd->bhqk', qb, k_sel).astype(f32) * scale
        logits = jnp.where(valid[:, None], logits, NEG_INF)
        prob = jax.nn.softmax(logits, axis=-1).astype(dt)
        return jnp.einsum('bhqk,bqkhd->bqhd', prob, v_sel)

    blk = lambda t: jnp.moveaxis(t.reshape((bsz, nb, Q_BLOCK) + t.shape[2:]), 1, 0)
    starts = jnp.arange(nb, dtype=jnp.int32) * Q_BLOCK
    out = lax.map(block, (blk(q), blk(qi), blk(wi), starts))
    return jnp.moveaxis(out, 0, 1).reshape(bsz, seq, DSA_WIDTH)


def _pool_mix(xc, pool_w, pool_scale):
    bsz, seq, _ = xc.shape
    xg = xc.reshape(bsz, seq, POOL_GROUPS, POOL_GROUP_DIM)
    cs = jnp.pad(jnp.cumsum(xg.astype(jnp.float32), axis=1), ((0, 0), (1, 0), (0, 0), (0, 0)))
    t_idx = jnp.arange(seq, dtype=jnp.float32)
    pooled = []
    for gi, w in enumerate(POOL_WINDOWS):
        csg = cs[:, :, gi]
        upper = csg[:, 1:]
        lower = jnp.pad(csg, ((0, 0), (w - 1, 0), (0, 0)))[:, :seq]
        count = jnp.minimum(t_idx + 1.0, float(w))[None, :, None]
        pooled.append((upper - lower) / count)
    pooled = jnp.stack(pooled, axis=2).astype(xc.dtype) - xg
    y = jnp.einsum('btgc,gcd->btgd', pooled, pool_w).reshape(bsz, seq, POOL_WIDTH)
    return y * pool_scale


def _sgu_mix(u, v, ln_g, ln_b, w_s, b_s):
    bsz, seq, _ = u.shape
    u = jax.nn.gelu(u, approximate=False)
    v = _layer_norm(jax.nn.gelu(v, approximate=False), ln_g, ln_b)
    vb = v.reshape(bsz, seq // SG_CHUNK, SG_CHUNK, SG_GROUPS, SG_GROUP_DIM)
    ws = w_s * jnp.tril(jnp.ones((SG_CHUNK, SG_CHUNK), w_s.dtype))[None]
    z = jnp.einsum('gts,bnsgc->bntgc', ws, vb) + b_s.T[:, :, None]
    return u * z.reshape(bsz, seq, SG_WIDTH)


def _conv_ffn(h, w_up, conv_w, conv_b, w_down):
    seq = h.shape[1]
    u = h @ w_up
    up = jnp.pad(u, ((0, 0), (CONV_WIDTH - 1, 0), (0, 0)))
    u = conv_b + sum(up[:, i:i + seq] * conv_w[i] for i in range(CONV_WIDTH))
    gate, val = jnp.split(u, 2, axis=-1)
    return (jax.nn.silu(gate) * val) @ w_down


def setup_inputs(seed: int = 0) -> dict:
    key = jax.random.key(seed)
    ks = iter(jax.random.split(key, 48))
    nrm = lambda shape, s: jax.random.normal(next(ks), shape, jnp.float32) * s
    uni = lambda shape, lo, hi: jax.random.uniform(next(ks), shape, jnp.float32, lo, hi)
    E, O, L, D = N_EVEN, N_ODD, DEPTH, D_MODEL
    return {
        'x': nrm((BATCH, SEQ, D), 1.0),
        'c': nrm((BATCH, D), 1.0),
        'ada_w': nrm((L, D, 6 * D), 0.5 * D ** -0.5),
        'ada_b': nrm((L, 6 * D), 0.01),
        'ln_g': 1.0 + nrm((L, 2, D), 0.02),
        'ln_b': nrm((L, 2, D), 0.02),
        'ffn_w_up': nrm((L, D, 2 * D_FF), D ** -0.5),
        'ffn_conv_w': nrm((L, CONV_WIDTH, 2 * D_FF), CONV_WIDTH ** -0.5),
        'ffn_conv_b': nrm((L, 2 * D_FF), 0.02),
        'ffn_w_down': nrm((L, D_FF, D), BETA * D_FF ** -0.5),
        'ev_w_in': nrm((E, D, EVEN_COLS), D ** -0.5),
        'ev_w_out': nrm((E, D, D), BETA * D ** -0.5),
        'rw_mu': uni((E, RWKV_COLS), 0.0, 1.0),
        'rw_w0': uni((E, RWKV_WIDTH), -5.0, 1.0),
        'rw_w2': nrm((E, RWKV_LORA_W, RWKV_WIDTH), 0.5 * RWKV_LORA_W ** -0.5),
        'rw_a0': nrm((E, RWKV_WIDTH), 0.1),
        'rw_a2': nrm((E, RWKV_LORA_A, RWKV_WIDTH), RWKV_LORA_A ** -0.5),
        'rw_g2': nrm((E, RWKV_LORA_G, RWKV_WIDTH), RWKV_LORA_G ** -0.5),
        'rw_k_k': 0.85 + nrm((E, RWKV_WIDTH), 0.05),
        'rw_k_a': 1.0 + nrm((E, RWKV_WIDTH), 0.05),
        'rw_r_k': nrm((E, RWKV_HEADS, HEAD_DIM), 0.1),
        'rw_gn_g': 1.0 + nrm((E, RWKV_WIDTH), 0.02),
        'rw_gn_b': nrm((E, RWKV_WIDTH), 0.02),
        'ik_ln_g': 1.0 + nrm((E, IDX_DIM), 0.02),
        'ik_ln_b': nrm((E, IDX_DIM), 0.02),
        'od_w_in': nrm((O, D, ODD_COLS), D ** -0.5),
        'od_w_out': nrm((O, D, D), BETA * D ** -0.5),
        'pool_w': nrm((O, POOL_GROUPS, POOL_GROUP_DIM, POOL_GROUP_DIM), POOL_GROUP_DIM ** -0.5),
        'pool_scale': 1.0 + nrm((O, POOL_WIDTH), 0.1),
        'sg_ln_g': 1.0 + nrm((O, SG_WIDTH), 0.02),
        'sg_ln_b': nrm((O, SG_WIDTH), 0.02),
        'sg_w': nrm((O, SG_GROUPS, SG_CHUNK, SG_CHUNK), 0.5 * SG_CHUNK ** -0.5),
        'sg_b': 1.0 + nrm((O, SG_GROUPS, SG_CHUNK), 0.02),
    }


def reference(x, c, ada_w, ada_b, ln_g, ln_b, ffn_w_up, ffn_conv_w, ffn_conv_b, ffn_w_down,
              ev_w_in, ev_w_out, rw_mu, rw_w0, rw_w2, rw_a0, rw_a2, rw_g2, rw_k_k, rw_k_a, rw_r_k,
              rw_gn_g, rw_gn_b, ik_ln_g, ik_ln_b,
              od_w_in, od_w_out, pool_w, pool_scale, sg_ln_g, sg_ln_b, sg_w, sg_b):
    seq = x.shape[1]
    cos, sin = _rope_tables(seq)
    c_act = jax.nn.silu(c)
    for layer in range(DEPTH):
        mod = c_act @ ada_w[layer] + ada_b[layer]
        sh1, sc1, g1, sh2, sc2, g2 = [m[:, None, :] for m in jnp.split(mod, 6, axis=-1)]
        h = x * (1 + sc1) + sh1
        if layer % 2 == 0:
            e = layer // 2
            p = h @ ev_w_in[e]
            ya = _rwkv7_mix(p[..., :RWKV_COLS], rw_mu[e], rw_w0[e], rw_w2[e], rw_a0[e], rw_a2[e],
                            rw_g2[e], rw_k_k[e], rw_k_a[e], rw_r_k[e], rw_gn_g[e], rw_gn_b[e])
            yb = _dsa_mix(p[..., RWKV_COLS:], cos, sin, ik_ln_g[e], ik_ln_b[e])
            y = jnp.concatenate([ya, yb], axis=-1) @ ev_w_out[e]
        else:
            o = layer // 2
            p = h @ od_w_in[o]
            yc = _pool_mix(p[..., :POOL_WIDTH], pool_w[o], pool_scale[o])
            yd = _sgu_mix(p[..., POOL_WIDTH:POOL_WIDTH + SG_WIDTH], p[..., POOL_WIDTH + SG_WIDTH:],
                          sg_ln_g[o], sg_ln_b[o], sg_w[o], sg_b[o])
            y = jnp.concatenate([yc, yd], axis=-1) @ od_w_out[o]
        x = _layer_norm(ALPHA * x + g1 * y, ln_g[layer, 0], ln_b[layer, 0])
        h = x * (1 + sc2) + sh2
        y = _conv_ffn(h, ffn_w_up[layer], ffn_conv_w[layer], ffn_conv_b[layer], ffn_w_down[layer])
        x = _layer_norm(ALPHA * x + g2 * y, ln_g[layer, 1], ln_b[layer, 1])
    return x
```

```cpp
#include <hip/hip_runtime.h>
#include <hip/hip_cooperative_groups.h>
#include <cstdio>
#include <cstdint>
namespace cg = cooperative_groups;
namespace pg8 {
#define PG8_LAS __attribute__((address_space(3)))
typedef unsigned short bf16_t;
typedef short bf16x8 __attribute__((ext_vector_type(8)));
typedef float f32x4 __attribute__((ext_vector_type(4)));
typedef unsigned u32x4 __attribute__((ext_vector_type(4)));
constexpr int BM = 256, BK = 64, HALF = 128, HTB = HALF * BK * 2  , STAGE_BYTES = 8 * HTB, NXCD = 8, WGM = 8;

__host__ __device__ __forceinline__ int lds_byte(int r, int c) { const int st = (r >> 4) * 2 + (c >> 5), rr = r & 15, cc = c & 31, ob = rr * 64 + cc * 2; return st * 1024 + (ob ^ (((ob >> 9) & 1) << 5)); }
__host__ __device__ __forceinline__ void stage_rc(int b, int& R, int& C) { const int st = b / 1024, sb = b % 1024, swz = sb ^ (((sb >> 9) & 1) << 5); R = (st >> 1) * 16 + swz / 64; C = (st & 1) * 32 + (swz % 64) / 2; }
__host__ __device__ __forceinline__ int perm32(int rho) { const int n = rho >> 4, i = rho & 15; return 8 * (i >> 2) + 4 * n + (i & 3); }

struct Unit { int pm, pn; };
struct Gemm { const bf16_t* A; const bf16_t* Bt; int M, N, K; };

struct StaticOrder {
    int nM, nN, nwg, G, c;
    __host__ __device__ void init(int M, int N, int G_, int c_) { nM = M / BM; nN = N / BM; nwg = nM * nN; G = G_; c = c_; }
    __host__ __device__ bool next(int i, Unit& u) const {
        const long L = (long)i * G + c; if (L >= nwg) return false;
        int wgid = (int)L; { const int q = nwg / NXCD, r = nwg % NXCD, xcd = wgid % NXCD, off = wgid / NXCD; wgid = (xcd < r ? xcd * (q + 1) : r * (q + 1) + (xcd - r) * q) + off; }
        const int nig = WGM * nN, gid = wgid / nig, fm = gid * WGM, gsz = (nM - fm) < WGM ? (nM - fm) : WGM;
        u.pm = fm + ((wgid % nig) % gsz); u.pn = (wgid % nig) / gsz; return true;
    }
    __device__ __forceinline__ void a_ready(const Unit&) const {}
    __device__ __forceinline__ void done(const Unit&) const {}
};

__device__ __forceinline__ unsigned cvt_pk_bf16(float lo, float hi) { unsigned r; asm volatile("v_cvt_pk_bf16_f32 %0, %1, %2" : "=v"(r) : "v"(lo), "v"(hi)); return r; }
template <class Epi, class Sched, bool ALIGN_EPI = false, bool SP2 = false>
__device__ __forceinline__ void gemm_phase(PG8_LAS unsigned char* lds, const Gemm g, const Sched& S, const Epi& E, const int tid) {
    const int wid = __builtin_amdgcn_readfirstlane(tid >> 6), lane = tid & 63, wr = wid >> 2, wc = wid & 3, fr = lane & 15, fq = lane >> 4;
    const int K = g.K, nt = K / BK;
    unsigned voffA[2], voffB[2];
#pragma unroll
    for (int i = 0; i < 2; ++i) { int R, C; stage_rc(tid * 16 + i * 8192, R, C); const int Rb = Epi::PERM ? ((R & ~31) + perm32(R & 31)) : R;
        voffA[i] = (unsigned)(R * K + C) * 2u; voffB[i] = (unsigned)(Rb * K + C) * 2u; }
    const size_t kstep = (size_t)(BK * 2);
    const size_t hstep = (size_t)HALF * K * 2;
    const size_t tstep = 2 * hstep;
    const unsigned ldsw = (unsigned)wid * 1024u;
    const int aoff = lds_byte(wr * 64 + fr, fq * 8), boff = lds_byte(wc * 32 + fr, fq * 8);
#define PG8_SA(b, h) (((b) * 2 + (h)) * HTB)
#define PG8_SB(b, h) ((4 + (b) * 2 + (h)) * HTB)
#define PG8_STAGE(bufoff, gbase, voff) do { _Pragma("unroll") for (int _i = 0; _i < 2; ++_i) \
        __builtin_amdgcn_global_load_lds((const unsigned*)((const char*)(gbase) + (voff)[_i]), (PG8_LAS unsigned*)(lds + (bufoff) + ldsw + _i * 8192), 16, 0, 0); } while (0)
#define PG8_LDA(dst, b, h) do { _Pragma("unroll") for (int m = 0; m < 4; ++m) _Pragma("unroll") for (int k = 0; k < 2; ++k) dst[m][k] = *(const PG8_LAS bf16x8*)(lds + PG8_SA(b, h) + aoff + m * 2048 + k * 1024); } while (0)
#define PG8_LDB(dst, b, h) do { _Pragma("unroll") for (int n = 0; n < 2; ++n) _Pragma("unroll") for (int k = 0; k < 2; ++k) dst[n][k] = *(const PG8_LAS bf16x8*)(lds + PG8_SB(b, h) + boff + n * 2048 + k * 1024); } while (0)
#define PG8_MMA(ai, bj, At, Bt) do { __builtin_amdgcn_s_setprio(1); _Pragma("unroll") for (int m = 0; m < 4; ++m) _Pragma("unroll") for (int n = 0; n < 2; ++n) _Pragma("unroll") for (int k = 0; k < 2; ++k) \
        acc[ai][bj][m][n] = __builtin_amdgcn_mfma_f32_16x16x32_bf16(Bt[n][k], At[m][k], acc[ai][bj][m][n], 0, 0, 0); __builtin_amdgcn_s_setprio(0); } while (0)
#define PG8_WAIT_V(n) asm volatile("s_waitcnt vmcnt(" #n ")" ::: "memory")
#define PG8_WAIT_L(n) asm volatile("s_waitcnt lgkmcnt(" #n ")" ::: "memory")
#define PG8_BAR __builtin_amdgcn_s_barrier()
#define PG8_SCHED __builtin_amdgcn_sched_barrier(0)
    Unit cur, nxt; int ui = 0;
    if (!S.next(0, cur)) return;
    f32x4 acc[2][2][4][2];
#pragma unroll
    for (int a = 0; a < 2; ++a)
#pragma unroll
        for (int b = 0; b < 2; ++b)
#pragma unroll
            for (int m = 0; m < 4; ++m)
#pragma unroll
                for (int n = 0; n < 2; ++n) acc[a][b][m][n] = (f32x4){0.f, 0.f, 0.f, 0.f};
    bf16x8 At[4][2], B0[2][2], B1[2][2];
    const char* cA = (const char*)g.A + (size_t)cur.pm * tstep; const char* cB = (const char*)g.Bt + (size_t)cur.pn * tstep;
    S.a_ready(cur);
    if constexpr (SP2) {
        PG8_STAGE(PG8_SB(0, 0), cB, voffB); PG8_STAGE(PG8_SB(0, 1), cB + hstep, voffB); PG8_STAGE(PG8_SA(0, 0), cA, voffA); PG8_STAGE(PG8_SA(0, 1), cA + hstep, voffA);
        if (wr == 1) PG8_BAR;
        PG8_WAIT_V(2); PG8_BAR;
        PG8_STAGE(PG8_SB(1, 0), cB + kstep, voffB); PG8_STAGE(PG8_SA(1, 0), cA + kstep, voffA); PG8_STAGE(PG8_SB(1, 1), cB + hstep + kstep, voffB);
        PG8_WAIT_V(6); PG8_BAR;
    } else {
        PG8_STAGE(PG8_SB(0, 0), cB, voffB); PG8_STAGE(PG8_SA(0, 0), cA, voffA); PG8_STAGE(PG8_SB(0, 1), cB + hstep, voffB); PG8_STAGE(PG8_SA(0, 1), cA + hstep, voffA);
        if (wr == 1) PG8_BAR;
        PG8_WAIT_V(4); PG8_BAR;
        PG8_STAGE(PG8_SB(1, 0), cB + kstep, voffB); PG8_STAGE(PG8_SA(1, 0), cA + kstep, voffA); PG8_STAGE(PG8_SB(1, 1), cB + hstep + kstep, voffB);
        PG8_WAIT_V(6); PG8_BAR;
    }
    for (;;) {
        const bool has_next = S.next(ui + 1, nxt);
        const char* nA = has_next ? (const char*)g.A + (size_t)nxt.pm * tstep : cA; const char* nB = has_next ? (const char*)g.Bt + (size_t)nxt.pn * tstep : cB;
        for (int t = 0; t < nt; t += 2) {
            const bool last = (t == nt - 2);
            const char* a1 = cA + (size_t)(t + 1) * kstep;
            const char* a2 = last ? nA : cA + (size_t)(t + 2) * kstep; const char* b2 = last ? nB : cB + (size_t)(t + 2) * kstep;
            const char* a3 = a2 + kstep; const char* b3 = b2 + kstep;
            if (last && has_next) S.a_ready(nxt);
            if constexpr (SP2) {
            PG8_LDB(B0, 0, 0); PG8_LDB(B1, 0, 1); PG8_SCHED; PG8_LDA(At, 0, 0); PG8_STAGE(PG8_SA(1, 1), a1 + hstep, voffA);
            PG8_WAIT_V(8); PG8_WAIT_L(0); PG8_BAR; PG8_MMA(0, 0, At, B0); PG8_MMA(0, 1, At, B1); PG8_BAR; PG8_SCHED;
            PG8_LDA(At, 0, 1); PG8_STAGE(PG8_SB(0, 0), b2, voffB); PG8_STAGE(PG8_SB(0, 1), b2 + hstep, voffB); PG8_STAGE(PG8_SA(0, 0), a2, voffA);
            PG8_WAIT_V(8); PG8_WAIT_L(0); PG8_BAR; PG8_MMA(1, 0, At, B0); PG8_MMA(1, 1, At, B1); PG8_BAR; PG8_SCHED;
            PG8_LDB(B0, 1, 0); PG8_LDB(B1, 1, 1); PG8_SCHED; PG8_LDA(At, 1, 0); PG8_STAGE(PG8_SA(0, 1), a2 + hstep, voffA);
            PG8_WAIT_V(8); PG8_WAIT_L(0); PG8_BAR; PG8_MMA(0, 0, At, B0); PG8_MMA(0, 1, At, B1); PG8_BAR; PG8_SCHED;
            PG8_LDA(At, 1, 1); PG8_STAGE(PG8_SB(1, 0), b3, voffB); PG8_STAGE(PG8_SB(1, 1), b3 + hstep, voffB); PG8_STAGE(PG8_SA(1, 0), a3, voffA);
            PG8_WAIT_V(8); PG8_WAIT_L(0); PG8_BAR; PG8_MMA(1, 0, At, B0); PG8_MMA(1, 1, At, B1); PG8_BAR; PG8_SCHED;
            } else {
            PG8_LDB(B0, 0, 0); PG8_SCHED; PG8_LDA(At, 0, 0); PG8_STAGE(PG8_SA(1, 1), a1 + hstep, voffA);
            PG8_WAIT_L(8); PG8_BAR; PG8_WAIT_L(0); PG8_MMA(0, 0, At, B0); PG8_BAR; PG8_SCHED;
            PG8_LDB(B1, 0, 1); PG8_STAGE(PG8_SB(0, 0), b2, voffB);
            PG8_BAR; PG8_WAIT_L(0); PG8_MMA(0, 1, At, B1); PG8_BAR;
            PG8_LDA(At, 0, 1); PG8_STAGE(PG8_SA(0, 0), a2, voffA);
            PG8_BAR; PG8_WAIT_L(0); PG8_MMA(1, 0, At, B0); PG8_BAR; PG8_SCHED;
            PG8_STAGE(PG8_SB(0, 1), b2 + hstep, voffB);
            PG8_WAIT_V(6); PG8_BAR; PG8_MMA(1, 1, At, B1); PG8_BAR;
            PG8_LDB(B0, 1, 0); PG8_SCHED; PG8_LDA(At, 1, 0); PG8_STAGE(PG8_SA(0, 1), a2 + hstep, voffA);
            PG8_WAIT_L(8); PG8_BAR; PG8_WAIT_L(0); PG8_MMA(0, 0, At, B0); PG8_BAR; PG8_SCHED;
            PG8_LDB(B1, 1, 1); PG8_STAGE(PG8_SB(1, 0), b3, voffB);
            PG8_BAR; PG8_WAIT_L(0); PG8_MMA(0, 1, At, B1); PG8_BAR;
            PG8_LDA(At, 1, 1); PG8_STAGE(PG8_SA(1, 0), a3, voffA);
            PG8_BAR; PG8_WAIT_L(0); PG8_MMA(1, 0, At, B0); PG8_BAR; PG8_SCHED;
            PG8_STAGE(PG8_SB(1, 1), b3 + hstep, voffB);
            PG8_WAIT_V(6); PG8_BAR; PG8_MMA(1, 1, At, B1); PG8_BAR;
            }
        }
        if constexpr (ALIGN_EPI) { if (wr == 0) PG8_BAR; }
        if constexpr (!Epi::AFTER_DRAIN) { E(acc, cur, wr, wc, fr, fq); S.done(cur); }
        if (!has_next) break;
#pragma unroll
        for (int a = 0; a < 2; ++a)
#pragma unroll
            for (int b = 0; b < 2; ++b)
#pragma unroll
                for (int m = 0; m < 4; ++m)
#pragma unroll
                    for (int n = 0; n < 2; ++n) acc[a][b][m][n] = (f32x4){0.f, 0.f, 0.f, 0.f};
        cur = nxt; cA = nA; cB = nB; ++ui;
        if constexpr (ALIGN_EPI) { if (wr == 1) PG8_BAR; }
    }
    PG8_WAIT_V(0);
    if constexpr (!ALIGN_EPI) { if (wr == 0) PG8_BAR; }
    PG8_BAR;
    if constexpr (Epi::AFTER_DRAIN) { E.fused(acc, cur, wr, wc, fr, fq, lds, wid, lane); S.done(cur); }
#undef PG8_SA
#undef PG8_SB
#undef PG8_STAGE
#undef PG8_LDA
#undef PG8_LDB
#undef PG8_MMA
#undef PG8_WAIT_V
#undef PG8_WAIT_L
#undef PG8_BAR
#undef PG8_SCHED
}
}

#define LAS __attribute__((address_space(3)))
using pg8::bf16_t; using pg8::bf16x8; using pg8::f32x4; using pg8::u32x4;
typedef unsigned u32x2 __attribute__((ext_vector_type(2)));
typedef unsigned long long u64;

constexpr int NT = 512;
constexpr int M = 32768, D = 1024, T = 8192, NB = 4;
constexpr int DFF = 2816, DFF2 = 5632;
constexpr int EVEN_COLS = 3652, EVEN_PAD = 3840, PR_LD = 1792, PD_LD = 2048, ODD_COLS = 1536;
constexpr float ALPHA = 1.681792830507429f;
constexpr float LN_EPS = 1e-5f, GN_EPS = 64e-5f;
constexpr int LDS_BYTES = 147456, TAB_OFF = 140288;
constexpr size_t MiB = 1u << 20;
constexpr size_t WS_MOD = 1 * MiB;
constexpr size_t WS_WIN = 2 * MiB, WS_WOUT = 10 * MiB, WS_WUP = 12 * MiB, WS_WDN = 24 * MiB;
constexpr size_t WS_SMALL = 30 * MiB;
constexpr size_t WS_H = 32 * MiB;
constexpr size_t WS_YC = 96 * MiB;
constexpr size_t WS_PR = 160 * MiB;
constexpr size_t WS_PD = 272 * MiB;
constexpr size_t WS_MASK = 400 * MiB;
constexpr size_t WS_SCRA = 96 * MiB, WS_SCRB = 432 * MiB;
constexpr size_t WS_E = 272 * MiB, WS_A = 304 * MiB, WS_G = 336 * MiB, WS_SINIT = 368 * MiB, WS_QP = 400 * MiB, WS_OU = 432 * MiB, WS_PU = 32 * MiB;
constexpr size_t WS_HID = 160 * MiB, WS_SIDE = 336 * MiB;
constexpr size_t WS_KC = 32 * MiB, WS_VC = 64 * MiB, WS_KI = 496 * MiB, WS_ROPE = 500 * MiB;
constexpr size_t WS_NEED = 512 * MiB;

__device__ __forceinline__ int otid_(int wv) { int l; asm volatile("v_mbcnt_lo_u32_b32 %0, -1, 0\n\tv_mbcnt_hi_u32_b32 %0, -1, %0" : "=v"(l)); return wv * 64 + l; }
__device__ __forceinline__ unsigned ozero() { unsigned z; asm volatile("v_mov_b32 %0, 0" : "=v"(z)); return z; }
__device__ __forceinline__ float bf2f(unsigned v) { return __builtin_bit_cast(float, v << 16); }
__device__ __forceinline__ unsigned f2bf(float f) { unsigned u = __builtin_bit_cast(unsigned, f); return (u + 0x7fffu + ((u >> 16) & 1u)) >> 16; }
__device__ __forceinline__ unsigned pk2(float lo, float hi) { return f2bf(lo) | (f2bf(hi) << 16); }
#ifndef USE_DPP_SUM
#define USE_DPP_SUM 1
#endif
__device__ __forceinline__ float dpp_row_shr(float v, int n) {
    const int iv = __builtin_bit_cast(int, v); int r;
    switch (n) { case 1: r = __builtin_amdgcn_update_dpp(0, iv, 0x111, 0xf, 0xf, true); break; case 2: r = __builtin_amdgcn_update_dpp(0, iv, 0x112, 0xf, 0xf, true); break;
                 case 4: r = __builtin_amdgcn_update_dpp(0, iv, 0x114, 0xf, 0xf, true); break; default: r = __builtin_amdgcn_update_dpp(0, iv, 0x118, 0xf, 0xf, true); break; }
    return __builtin_bit_cast(float, r);
}
__device__ __forceinline__ float wave_sum(float v) {
#if USE_DPP_SUM
    v += dpp_row_shr(v, 1); v += dpp_row_shr(v, 2); v += dpp_row_shr(v, 4); v += dpp_row_shr(v, 8);
    v += __builtin_bit_cast(float, __builtin_amdgcn_update_dpp(0, __builtin_bit_cast(int, v), 0x142, 0xa, 0xf, false));
    v += __builtin_bit_cast(float, __builtin_amdgcn_update_dpp(0, __builtin_bit_cast(int, v), 0x143, 0xc, 0xf, false));
    return __builtin_bit_cast(float, __builtin_amdgcn_readlane(__builtin_bit_cast(int, v), 63));
#else
#pragma unroll
    for (int o = 1; o < 64; o <<= 1) v += __shfl_xor(v, o);
    return v;
#endif
}
__device__ __forceinline__ f32x4 ld4(const float* p) { return *(const f32x4*)p; }
__device__ __forceinline__ float gelu_exact(float x) { return 0.5f * x * (1.f + erff(x * 0.70710678118654752f)); }
__device__ __forceinline__ float sigmoidf_(float x) { return 1.f / (1.f + expf(-x)); }
__device__ __forceinline__ void unpack8(u32x4 w, float* f) {
    f[0] = bf2f(w.x & 0xffffu); f[1] = bf2f(w.x >> 16); f[2] = bf2f(w.y & 0xffffu); f[3] = bf2f(w.y >> 16);
    f[4] = bf2f(w.z & 0xffffu); f[5] = bf2f(w.z >> 16); f[6] = bf2f(w.w & 0xffffu); f[7] = bf2f(w.w >> 16);
}
__device__ __forceinline__ bf16x8 pack8(const float* f) {
    u32x4 w; w.x = pk2(f[0], f[1]); w.y = pk2(f[2], f[3]); w.z = pk2(f[4], f[5]); w.w = pk2(f[6], f[7]);
    return __builtin_bit_cast(bf16x8, w);
}
#define MFMA16(a, b, c) __builtin_amdgcn_mfma_f32_16x16x32_bf16((a), (b), (c), 0, 0, 0)

namespace pg8 {
struct EpiStoreP {
    static constexpr bool PERM = true, AFTER_DRAIN = false;
    bf16_t* P0; int ld0; int ntile0; bf16_t* P1; int ld1;
    __device__ __forceinline__ void operator()(const f32x4 (&acc)[2][2][4][2], const Unit& u, int wr, int wc, int fr, int fq) const {
        bf16_t* base; int ld, colt;
        if (u.pn < ntile0) { base = P0; ld = ld0; colt = u.pn * 256; } else { base = P1; ld = ld1; colt = (u.pn - ntile0) * 256; }
        const int row0 = u.pm * BM + wr * 64 + fr, col0 = colt + wc * 32 + 8 * fq;
#pragma unroll
        for (int ai = 0; ai < 2; ++ai)
#pragma unroll
            for (int m = 0; m < 4; ++m) { bf16_t* rowp = base + (size_t)(row0 + ai * HALF + m * 16) * ld + col0;
#pragma unroll
                for (int bj = 0; bj < 2; ++bj) { const f32x4 v0 = acc[ai][bj][m][0], v1 = acc[ai][bj][m][1];
                    u32x4 w; w.x = cvt_pk_bf16(v0[0], v0[1]); w.y = cvt_pk_bf16(v0[2], v0[3]); w.z = cvt_pk_bf16(v1[0], v1[1]); w.w = cvt_pk_bf16(v1[2], v1[3]);
                    *(u32x4*)(rowp + bj * HALF) = w; } }
    }
};
struct EpiResid {
    static constexpr bool PERM = true, AFTER_DRAIN = false;
    const float* xsrc; float* X; const float* gate;
    __device__ __forceinline__ void operator()(const f32x4 (&acc)[2][2][4][2], const Unit& u, int wr, int wc, int fr, int fq) const {
        const int row0 = u.pm * BM + wr * 64 + fr, col0 = u.pn * BM + wc * 32 + 8 * fq;
#pragma unroll
        for (int ai = 0; ai < 2; ++ai)
#pragma unroll
            for (int m = 0; m < 4; ++m) { const int row = row0 + ai * HALF + m * 16; const float* gp = gate + (row >> 13) * 6144;
#pragma unroll
                for (int bj = 0; bj < 2; ++bj)
#pragma unroll
                    for (int n = 0; n < 2; ++n) { const int c = col0 + bj * HALF + 4 * n; const size_t o = (size_t)row * 1024 + c;
                        const f32x4 g = *(const f32x4*)(gp + c), xs = *(const f32x4*)(xsrc + o);
                        *(f32x4*)(X + o) = xs * 1.681792830507429f + g * acc[ai][bj][m][n]; } }
    }
};
struct EpiFFN {
    static constexpr bool PERM = true, AFTER_DRAIN = false;
    bf16_t* HID; float* side; const float* cw; const float* cb;
    __device__ __forceinline__ void operator()(const f32x4 (&acc)[2][2][4][2], const Unit& u, int wr, int wc, int fr, int fq) const {
        const int lane = fq * 16 + fr;
        const int src1 = (lane & 48) | ((fr + 15) & 15), src2 = (lane & 48) | ((fr + 14) & 15);
#pragma unroll
        for (int n = 0; n < 2; ++n) {
            const int hc = u.pn * 128 + wc * 32 + 8 * fq + 4 * n;
#pragma unroll
            for (int ai = 0; ai < 2; ++ai) {
                const int blk = u.pm * 4 + ai * 2 + wr;
                f32x4 pg1 = {0.f, 0.f, 0.f, 0.f}, pg2 = pg1, pv1 = pg1, pv2 = pg1;
#pragma unroll
                for (int m = 0; m < 4; ++m) {
                    const f32x4 cgv = acc[ai][0][m][n], cvv = acc[ai][1][m][n];
                    f32x4 rg1, rg2, rv1, rv2;
#pragma unroll
                    for (int j = 0; j < 4; ++j) { rg1[j] = __shfl(cgv[j], src1); rg2[j] = __shfl(cgv[j], src2); rv1[j] = __shfl(cvv[j], src1); rv2[j] = __shfl(cvv[j], src2); }
                    f32x4 ug1, ug2, uv1, uv2;
#pragma unroll
                    for (int j = 0; j < 4; ++j) { ug1[j] = fr >= 1 ? rg1[j] : pg1[j]; ug2[j] = fr >= 2 ? rg2[j] : pg2[j]; uv1[j] = fr >= 1 ? rv1[j] : pv1[j]; uv2[j] = fr >= 2 ? rv2[j] : pv2[j]; }
                    pg1 = rg1; pg2 = rg2; pv1 = rv1; pv2 = rv2;
                    const float* cwp = cw + hc; asm volatile("" : "+v"(cwp));
                    f32x4 gate = *(const f32x4*)(cb + hc) + *(const f32x4*)(cwp) * ug2 + *(const f32x4*)(cwp + 5632) * ug1 + *(const f32x4*)(cwp + 11264) * cgv;
                    float h[4];
#pragma unroll
                    for (int j = 0; j < 4; ++j) h[j] = gate[j] / (1.f + __expf(-gate[j]));
                    const f32x4 val = *(const f32x4*)(cb + 2816 + hc) + *(const f32x4*)(cwp + 2816) * uv2 + *(const f32x4*)(cwp + 5632 + 2816) * uv1 + *(const f32x4*)(cwp + 11264 + 2816) * cvv;
#pragma unroll
                    for (int j = 0; j < 4; ++j) h[j] *= val[j];
                    const int row = u.pm * BM + ai * HALF + wr * 64 + m * 16 + fr;
                    if (!(m == 0 && fr < 2)) { u32x2 w; w.x = cvt_pk_bf16(h[0], h[1]); w.y = cvt_pk_bf16(h[2], h[3]); *(u32x2*)(HID + (size_t)row * 2816 + hc) = w; }
                    if (m == 0 && fr < 2) { float* sp = side + (size_t)(blk * 4 + fr) * 5632 + hc; *(f32x4*)sp = cgv; *(f32x4*)(sp + 2816) = cvv; }
                    if (m == 3 && fr >= 14) { float* sp = side + (size_t)(blk * 4 + 2 + (fr - 14)) * 5632 + hc; *(f32x4*)sp = cgv; *(f32x4*)(sp + 2816) = cvv; }
                }
            }
        }
    }
};
}

__device__ __forceinline__ void phase_mod(LAS unsigned char* lds, const float* c, const float* ada_w, const float* ada_b, float* MOD, int tid) {
    LAS float* cact = (LAS float*)lds;
    LAS float* red = cact + 4096;
    for (int i = tid; i < 4096; i += NT) { const float v = c[i]; cact[i] = v / (1.f + expf(-v)); }
    __syncthreads();
    const int nl = tid & 63, kg = tid >> 6;
    for (int u = blockIdx.x; u < 384; u += gridDim.x) {
        const int l = u / 96, n0 = (u % 96) * 64;
        const float* w = ada_w + ((size_t)l * 1024 + kg * 128) * 6144 + n0 + nl;
        float a0 = 0.f, a1 = 0.f, a2 = 0.f, a3 = 0.f;
#pragma unroll 8
        for (int k = 0; k < 128; ++k) { const float wv = w[(size_t)k * 6144]; const int kk = kg * 128 + k;
            a0 += cact[kk] * wv; a1 += cact[1024 + kk] * wv; a2 += cact[2048 + kk] * wv; a3 += cact[3072 + kk] * wv; }
        LAS float* r = red + (kg * 64 + nl) * 4; r[0] = a0; r[1] = a1; r[2] = a2; r[3] = a3;
        __syncthreads();
        if (tid < 256) { const int b = tid >> 6; float s = ada_b[l * 6144 + n0 + nl];
#pragma unroll
            for (int g = 0; g < 8; ++g) s += red[(g * 64 + nl) * 4 + b];
            MOD[(size_t)(l * 4 + b) * 6144 + n0 + nl] = s; }
        __syncthreads();
    }
}

template <int MODE>
__device__ __forceinline__ void cvt_item(const float* W, int K, int N, int Npad, bf16_t* WT, LAS float* scr, int item, int lane) {
    const int nblk = Npad / 32, kb = item / nblk, nb = item % nblk, k0 = 64 * kb, n0 = 32 * nb;
#pragma unroll 8
    for (int i = 0; i < 32; ++i) { const int kk = 2 * i + (lane >> 5), n = n0 + (lane & 31); scr[kk * 33 + (lane & 31)] = (n < N) ? W[(size_t)(k0 + kk) * N + n] : 0.f; }
    asm volatile("s_waitcnt lgkmcnt(0)" ::: "memory");
    const int c = lane & 7;
#pragma unroll
    for (int j = 0; j < 4; ++j) { const int nl = (lane >> 3) + 8 * j; const LAS float* s = scr + (8 * c) * 33 + nl;
        u32x4 o; o.x = pk2(s[0 * 33], s[1 * 33]); o.y = pk2(s[2 * 33], s[3 * 33]); o.z = pk2(s[4 * 33], s[5 * 33]); o.w = pk2(s[6 * 33], s[7 * 33]);
        int n = n0 + nl, row = n;
        if (MODE == 1) row = (n < 2816) ? ((n >> 7) * 256 + (n & 127)) : (((n - 2816) >> 7) * 256 + 128 + ((n - 2816) & 127));
        *(u32x4*)(WT + (size_t)row * K + k0 + 8 * c) = o; }
    asm volatile("s_waitcnt lgkmcnt(0)" ::: "memory");
}

struct CvtPtrs { const float *w_in, *w_out, *w_up, *w_dn, *s0, *s1, *s2; };
__device__ __forceinline__ void phase_convert(LAS unsigned char* lds, unsigned char* ws, const CvtPtrs cp, bool even, int tid) {
    const int wave = __builtin_amdgcn_readfirstlane(tid >> 6), lane = tid & 63;
    LAS float* scr = (LAS float*)lds + wave * (64 * 33 + 16);
    const int gw = blockIdx.x * 8 + wave, NGW = gridDim.x * 8;
    bf16_t* WIN = (bf16_t*)(ws + WS_WIN); bf16_t* WOUT = (bf16_t*)(ws + WS_WOUT); bf16_t* WUP = (bf16_t*)(ws + WS_WUP); bf16_t* WDN = (bf16_t*)(ws + WS_WDN);
    bf16_t* SM = (bf16_t*)(ws + WS_SMALL);
    const int n_in = even ? EVEN_COLS : ODD_COLS, npad_in = even ? EVEN_PAD : ODD_COLS;
    const int I_IN = 16 * (npad_in / 32), I_OUT = 16 * 32, I_UP = 16 * 176, I_DN = 44 * 32;
    const int I_S = even ? (16 + 16 + 32) : (4 * 8);
    const int total = I_IN + I_OUT + I_UP + I_DN + I_S;
    for (int it = gw; it < total; it += NGW) {
        int r = it;
        if (r < I_IN) { cvt_item<0>(cp.w_in, 1024, n_in, npad_in, WIN, scr, r, lane); continue; } r -= I_IN;
        if (r < I_OUT) { cvt_item<0>(cp.w_out, 1024, 1024, 1024, WOUT, scr, r, lane); continue; } r -= I_OUT;
        if (r < I_UP) { cvt_item<1>(cp.w_up, 1024, 5632, 5632, WUP, scr, r, lane); continue; } r -= I_UP;
        if (r < I_DN) { cvt_item<0>(cp.w_dn, 2816, 1024, 1024, WDN, scr, r, lane); continue; } r -= I_DN;
        if (even) {
            if (r < 16) { cvt_item<0>(cp.s0, 64, 512, 512, SM, scr, r, lane); continue; } r -= 16;
            if (r < 16) { cvt_item<0>(cp.s1, 64, 512, 512, SM + 32768, scr, r, lane); continue; } r -= 16;
            cvt_item<0>(cp.s2, 128, 512, 512, SM + 65536, scr, r, lane);
        } else {
            const int g = r >> 3; cvt_item<0>(cp.s0 + g * 16384, 128, 128, 128, SM + 131072 + g * 16384, scr, r & 7, lane);
        }
    }
    if (!even) {
        bf16_t* SGW = SM + 196608;
        for (int i = blockIdx.x * NT + tid; i < 65536; i += gridDim.x * NT) { const int s = i & 127, t = (i >> 7) & 127; SGW[i] = (bf16_t)f2bf(s <= t ? cp.s1[i] : 0.f); }
    }
}

__device__ __forceinline__ void phase_h0(const float* x, const float* MOD, bf16_t* H, int tid) {
    const int wave = __builtin_amdgcn_readfirstlane(tid >> 6), lane = tid & 63;
    for (int row = blockIdx.x * 8 + wave; row < M; row += gridDim.x * 8) {
        const float* mp = MOD + (size_t)(row >> 13) * 6144;
#pragma unroll
        for (int j = 0; j < 4; ++j) { const int c = 4 * (lane + 64 * j);
            const f32x4 v = ld4(x + (size_t)row * 1024 + c), sh = ld4(mp + c), sc = ld4(mp + 1024 + c);
            u32x2 w; w.x = pk2(v[0] * (1.f + sc[0]) + sh[0], v[1] * (1.f + sc[1]) + sh[1]); w.y = pk2(v[2] * (1.f + sc[2]) + sh[2], v[3] * (1.f + sc[3]) + sh[3]);
            *(u32x2*)(H + (size_t)row * 1024 + c) = w; }
    }
}

__device__ __forceinline__ void phase_ln(float* X, const float* lg, const float* lb, const float* modp  , bf16_t* H, int tid) {
    const int wave = __builtin_amdgcn_readfirstlane(tid >> 6), lane = tid & 63;
    const int stride = gridDim.x * 8;
    for (int row0 = blockIdx.x * 8 + wave; row0 < M; row0 += 4 * stride) {
        int rows[4];
#pragma unroll
        for (int u = 0; u < 4; ++u) rows[u] = (row0 + u * stride < M) ? row0 + u * stride : row0;
        f32x4 v[4][4];
#pragma unroll
        for (int u = 0; u < 4; ++u)
#pragma unroll
            for (int j = 0; j < 4; ++j) v[u][j] = ld4(X + (size_t)rows[u] * 1024 + 4 * (lane + 64 * j));
#pragma unroll
        for (int u = 0; u < 4; ++u) {
            if (u > 0 && rows[u] == rows[0]) break;
            const int row = rows[u];
            float s = 0.f;
#pragma unroll
            for (int j = 0; j < 4; ++j) s += (v[u][j][0] + v[u][j][1]) + (v[u][j][2] + v[u][j][3]);
            const float mean = wave_sum(s) * (1.f / 1024.f); float s2 = 0.f;
#pragma unroll
            for (int j = 0; j < 4; ++j) { v[u][j] = v[u][j] - mean; s2 += (v[u][j][0] * v[u][j][0] + v[u][j][1] * v[u][j][1]) + (v[u][j][2] * v[u][j][2] + v[u][j][3] * v[u][j][3]); }
            const float rstd = 1.f / sqrtf(wave_sum(s2) * (1.f / 1024.f) + LN_EPS);
#pragma unroll
            for (int j = 0; j < 4; ++j) { const int c = 4 * (lane + 64 * j);
                const f32x4 y = v[u][j] * rstd * ld4(lg + c) + ld4(lb + c);
                *(f32x4*)(X + (size_t)row * 1024 + c) = y;
                if (modp) { const float* mp = modp + (size_t)(row >> 13) * 6144; const f32x4 sh = ld4(mp + c), sc = ld4(mp + 1024 + c);
                    u32x2 w; w.x = pk2(y[0] * (1.f + sc[0]) + sh[0], y[1] * (1.f + sc[1]) + sh[1]); w.y = pk2(y[2] * (1.f + sc[2]) + sh[2], y[3] * (1.f + sc[3]) + sh[3]);
                    *(u32x2*)(H + (size_t)row * 1024 + c) = w; }
            }
        }
    }
}

__device__ __forceinline__ void phase_ffn_fix(const float* side, const float* cw, const float* cb, bf16_t* HID, int tid) {
    for (int idx = blockIdx.x * NT + tid; idx < 512 * 2 * 2816; idx += gridDim.x * NT) {
        const int col = idx % 2816, q = (idx / 2816) & 1, blk = idx / 5632;
        const bool first = ((blk * 64) & 8191) == 0;
        const float* s0 = side + (size_t)(blk * 4) * 5632;
        const float* sp = side + (size_t)(blk * 4 - 4) * 5632;
        float g0 = s0[q * 5632 + col], v0 = s0[q * 5632 + 2816 + col], g1, v1, g2, v2;
        if (q == 1) { g1 = s0[col]; v1 = s0[2816 + col]; g2 = first ? 0.f : sp[3 * 5632 + col]; v2 = first ? 0.f : sp[3 * 5632 + 2816 + col]; }
        else { g1 = first ? 0.f : sp[3 * 5632 + col]; v1 = first ? 0.f : sp[3 * 5632 + 2816 + col]; g2 = first ? 0.f : sp[2 * 5632 + col]; v2 = first ? 0.f : sp[2 * 5632 + 2816 + col]; }
        const float gate = cb[col] + cw[col] * g2 + cw[5632 + col] * g1 + cw[11264 + col] * g0;
        const float val = cb[2816 + col] + cw[2816 + col] * v2 + cw[5632 + 2816 + col] * v1 + cw[11264 + 2816 + col] * v0;
        HID[(size_t)(blk * 64 + q) * 2816 + col] = (bf16_t)f2bf(gate / (1.f + expf(-gate)) * val);
    }
}

__device__ __forceinline__ void phase_pool(const bf16_t* P, const bf16_t* POOLT, const float* pscale, bf16_t* YC, int tid) {
    const int wave = __builtin_amdgcn_readfirstlane(tid >> 6), lane = tid & 63, l15 = lane & 15, quad = lane >> 4;
    for (int uid = blockIdx.x * 8 + wave; uid < 8192; uid += gridDim.x * 8) {
        const int g = uid & 3, row0 = (uid >> 2) * 16, row = row0 + l15, t = row & 8191, w = 2 << g;
        const float inv = 1.f / (float)((t + 1 < w) ? (t + 1) : w);
        bf16x8 afr[4];
#pragma unroll
        for (int ks = 0; ks < 4; ++ks) {
            const int c0 = g * 128 + ks * 32 + quad * 8;
            float sum[8], x0[8];
            unpack8(*(const u32x4*)(P + (size_t)row * 1536 + c0), x0);
#pragma unroll
            for (int j = 0; j < 8; ++j) sum[j] = x0[j];
            for (int d = 1; d < w; ++d) if (t - d >= 0) { float xv[8]; unpack8(*(const u32x4*)(P + (size_t)(row - d) * 1536 + c0), xv);
#pragma unroll
                for (int j = 0; j < 8; ++j) sum[j] += xv[j]; }
#pragma unroll
            for (int j = 0; j < 8; ++j) sum[j] = sum[j] * inv - x0[j];
            afr[ks] = pack8(sum);
        }
#pragma unroll
        for (int nt = 0; nt < 8; ++nt) {
            f32x4 acc = {0.f, 0.f, 0.f, 0.f};
#pragma unroll
            for (int ks = 0; ks < 4; ++ks) { const bf16x8 wb = *(const bf16x8*)(POOLT + g * 16384 + (16 * nt + l15) * 128 + ks * 32 + quad * 8); acc = MFMA16(wb, afr[ks], acc); }
            const int d0 = g * 128 + 16 * nt + 4 * quad; const f32x4 sc = ld4(pscale + d0);
            u32x2 o; o.x = pk2(acc[0] * sc[0], acc[1] * sc[1]); o.y = pk2(acc[2] * sc[2], acc[3] * sc[3]);
            *(u32x2*)(YC + (size_t)row * 1024 + d0) = o;
        }
    }
}

__device__ __forceinline__ void phase_sgu(LAS unsigned char* lds, const bf16_t* P, const bf16_t* SGW, const float* lng, const float* lnb, const float* sgb, bf16_t* YC, int tid) {
    const int wave = __builtin_amdgcn_readfirstlane(tid >> 6), lane = tid & 63, l15 = lane & 15, quad = lane >> 4;
    LAS bf16_t* Vt = (LAS bf16_t*)lds;
    for (int u = blockIdx.x; u < 256; u += gridDim.x) {
        const int row0 = u * 128;
        {
            const int c0 = lane * 8; float gam[8], bet[8];
#pragma unroll
            for (int j = 0; j < 8; ++j) { gam[j] = lng[c0 + j]; bet[j] = lnb[c0 + j]; }
#pragma unroll 4
            for (int si = 0; si < 16; ++si) {
                const int s = wave * 16 + si; float v[8];
                unpack8(*(const u32x4*)(P + (size_t)(row0 + s) * 1536 + 1024 + c0), v);
                float sm = 0.f;
#pragma unroll
                for (int j = 0; j < 8; ++j) { v[j] = gelu_exact(v[j]); sm += v[j]; }
                const float mean = wave_sum(sm) * (1.f / 512.f); float s2 = 0.f;
#pragma unroll
                for (int j = 0; j < 8; ++j) { v[j] -= mean; s2 += v[j] * v[j]; }
                const float rstd = 1.f / sqrtf(wave_sum(s2) * (1.f / 512.f) + LN_EPS);
#pragma unroll
                for (int j = 0; j < 8; ++j) Vt[(c0 + j) * 136 + s] = (bf16_t)f2bf(v[j] * rstd * gam[j] + bet[j]);
            }
        }
        __syncthreads();
        {
            const int t = wave * 16 + l15, nks = (wave * 16 + 15) / 32 + 1;
            for (int g = 0; g < 4; ++g) {
                bf16x8 wf[4];
#pragma unroll
                for (int ks = 0; ks < 4; ++ks) if (ks < nks) wf[ks] = *(const bf16x8*)(SGW + g * 16384 + t * 128 + ks * 32 + quad * 8); else wf[ks] = (bf16x8){0, 0, 0, 0, 0, 0, 0, 0};
                const float bs = sgb[g * 128 + t];
#pragma unroll
                for (int nt = 0; nt < 8; ++nt) {
                    f32x4 acc = {0.f, 0.f, 0.f, 0.f};
#pragma unroll
                    for (int ks = 0; ks < 4; ++ks) if (ks < nks) { const bf16x8 vf = *(const LAS bf16x8*)(Vt + (g * 128 + 16 * nt + l15) * 136 + ks * 32 + quad * 8); acc = MFMA16(vf, wf[ks], acc); }
                    const int c = g * 128 + 16 * nt + 4 * quad;
                    const u32x2 uw = *(const u32x2*)(P + (size_t)(row0 + t) * 1536 + 512 + c);
                    const float u0 = gelu_exact(bf2f(uw.x & 0xffffu)), u1 = gelu_exact(bf2f(uw.x >> 16)), u2 = gelu_exact(bf2f(uw.y & 0xffffu)), u3 = gelu_exact(bf2f(uw.y >> 16));
                    u32x2 o; o.x = pk2(u0 * (acc[0] + bs), u1 * (acc[1] + bs)); o.y = pk2(u2 * (acc[2] + bs), u3 * (acc[3] + bs));
                    *(u32x2*)(YC + (size_t)(row0 + t) * 1024 + 512 + c) = o;
                }
            }
        }
        __syncthreads();
    }
}

__device__ __forceinline__ void phase_rope_table(float* ROPE, int tid) {
    for (int i = blockIdx.x * NT + tid; i < 8192 * 8; i += gridDim.x * NT) { const int t = i >> 3, f = i & 7;
        const float ang = (float)t * powf(500000.0f, -(float)(2 * f) / 16.0f); ROPE[t * 16 + f] = cosf(ang); ROPE[t * 16 + 8 + f] = sinf(ang); }
}
__device__ __forceinline__ void phase_dsa_prep(bf16_t* PD, const float* ikg, const float* ikb, const float* ROPE, bf16_t* Kc, bf16_t* Vc, bf16_t* KI, int tid) {
    const int wave = __builtin_amdgcn_readfirstlane(tid >> 6), lane = tid & 63, f = lane & 7;
    const float g = ikg[lane], bb = ikb[lane];
    for (int row = blockIdx.x * 8 + wave; row < M; row += gridDim.x * 8) {
        bf16_t* pd = PD + (size_t)row * PD_LD;
        const int t = row & 8191, b = row >> 13;
        const float* rt = ROPE + t * 16;
        const float cs = rt[f], sn = rt[8 + f];
#pragma unroll
        for (int i = 0; i < 2; ++i) { const int p = lane + 64 * i;
            if (p < 96) { const int head = p >> 3; const int base = head < 8 ? head * 64 : 1536 + (head - 8) * 64;
                const float x1 = bf2f(pd[base + f]), x2 = bf2f(pd[base + 8 + f]);
                pd[base + f] = (bf16_t)f2bf(x1 * cs - x2 * sn); pd[base + 8 + f] = (bf16_t)f2bf(x1 * sn + x2 * cs); } }
        {
            const int head = lane >> 3, seg = lane & 7;
            u32x4 kw = *(const u32x4*)(pd + 512 + head * 64 + seg * 8);
            const u32x4 vw = *(const u32x4*)(pd + 1024 + head * 64 + seg * 8);
            u32x4 kx; kx.x = __shfl_xor(kw.x, 1); kx.y = __shfl_xor(kw.y, 1); kx.z = __shfl_xor(kw.z, 1); kx.w = __shfl_xor(kw.w, 1);
            if (seg < 2) {
                float a[8], o8[8], c8[8], s8[8]; unpack8(kw, a); unpack8(kx, o8);
                const f32x4 c0 = ld4(rt), c1 = ld4(rt + 4), s0 = ld4(rt + 8), s1 = ld4(rt + 12);
                c8[0] = c0[0]; c8[1] = c0[1]; c8[2] = c0[2]; c8[3] = c0[3]; c8[4] = c1[0]; c8[5] = c1[1]; c8[6] = c1[2]; c8[7] = c1[3];
                s8[0] = s0[0]; s8[1] = s0[1]; s8[2] = s0[2]; s8[3] = s0[3]; s8[4] = s1[0]; s8[5] = s1[1]; s8[6] = s1[2]; s8[7] = s1[3];
#pragma unroll
                for (int j = 0; j < 8; ++j) a[j] = (seg == 0) ? (a[j] * c8[j] - o8[j] * s8[j]) : (o8[j] * s8[j] + a[j] * c8[j]);
                kw = __builtin_bit_cast(u32x4, pack8(a));
            }
            const size_t co = ((size_t)((b * 8 + head) * 8192 + t)) * 64 + seg * 8;
            *(u32x4*)(Kc + co) = kw; *(u32x4*)(Vc + co) = vw;
        }
        const float v = bf2f(pd[1792 + lane]);
        const float mean = wave_sum(v) * (1.f / 64.f), d = v - mean, var = wave_sum(d * d) * (1.f / 64.f);
        const float y = d * (1.f / sqrtf(var + LN_EPS)) * g + bb;
        const float yp = __shfl(y, lane < 8 ? lane + 8 : (lane < 16 ? lane - 8 : lane));
        float o = y;
        if (lane < 8) o = y * cs - yp * sn; else if (lane < 16) o = yp * sn + y * cs;
        KI[(size_t)row * 64 + lane] = (bf16_t)f2bf(o);
        if (lane < 4) pd[1856 + lane] = (bf16_t)f2bf(bf2f(pd[1856 + lane]) * 0.0625f);
    }
}

__device__ __forceinline__ unsigned fkey(float s) { const unsigned u = __builtin_bit_cast(unsigned, s); return (u & 0x80000000u) ? ~u : (u | 0x80000000u); }

__device__ __forceinline__ void phase_dsa_select(LAS unsigned char* lds, const bf16_t* PD, const bf16_t* KI, float* scr, u64* MASK, int tid) {
    const int wave = __builtin_amdgcn_readfirstlane(tid >> 6), lane = tid & 63, l15 = lane & 15, quad = lane >> 4;
    LAS unsigned* hist = (LAS unsigned*)lds + wave * 1024;
    const int G = gridDim.x, bid = blockIdx.x;
    for (int it = 0;; ++it) {
        const int uo = it * G + ((it & 1) ? (G - 1 - bid) : bid);
        if (uo >= 2048) break;
        const int tq = 511 - (uo >> 2), b = uo & 3, t0 = tq * 16, c = t0 >> 6, nkeys = (c + 1) * 64, row0 = b * 8192 + t0;
        if (c <= 3) {
            for (int idx = tid; idx < 16 * (c + 1); idx += NT) { const int q = idx / (c + 1), j = idx % (c + 1); const unsigned on = ~ozero(); MASK[(size_t)(row0 + q) * 128 + j] = ((u64)on << 32) | on; }
            continue;
        }
        {
            bf16x8 qa[4][2]; float wq[4][4];
#pragma unroll
            for (int h = 0; h < 4; ++h)
#pragma unroll
                for (int ks = 0; ks < 2; ++ks) qa[h][ks] = *(const bf16x8*)(PD + (size_t)(row0 + l15) * PD_LD + 1536 + h * 64 + ks * 32 + quad * 8);
#pragma unroll
            for (int r = 0; r < 4; ++r)
#pragma unroll
                for (int h = 0; h < 4; ++h) wq[r][h] = bf2f(PD[(size_t)(row0 + quad * 4 + r) * PD_LD + 1856 + h]);
            const bf16_t* kbase = KI + (size_t)(b * 8192 + l15) * 64 + quad * 8;
            const int ntile = nkeys / 16;
            for (int t0 = wave; t0 < ntile; t0 += 32) {
                bf16x8 kb[4][2];
#pragma unroll
                for (int i = 0; i < 4; ++i) { const int tl = (t0 + 8 * i < ntile) ? t0 + 8 * i : t0; const bf16_t* kp = kbase + (size_t)(tl * 16) * 64; kb[i][0] = *(const bf16x8*)kp; kb[i][1] = *(const bf16x8*)(kp + 32); }
#pragma unroll
                for (int i = 0; i < 4; ++i) if (t0 + 8 * i < ntile) {
                    const int key0 = (t0 + 8 * i) * 16;
                    float sc[4] = {0.f, 0.f, 0.f, 0.f};
#pragma unroll
                    for (int h = 0; h < 4; ++h) { f32x4 a = {0.f, 0.f, 0.f, 0.f}; a = MFMA16(qa[h][0], kb[i][0], a); a = MFMA16(qa[h][1], kb[i][1], a);
#pragma unroll
                        for (int r = 0; r < 4; ++r) sc[r] += wq[r][h] * fmaxf(a[r], 0.f); }
#pragma unroll
                    for (int r = 0; r < 4; ++r) { float sv = sc[r]; if (sv == 0.f) sv = 0.f; const int key = key0 + l15, e = key >> 6;
                        scr[(size_t)(quad * 4 + r) * 8192 + (e >> 2) * 256 + (key & 63) * 4 + (e & 3)] = sv; }
                }
            }
        }
        __syncthreads();
        for (int qi = 0; qi < 2; ++qi) {
            const int qq = wave * 2 + qi; const float* sbase = scr + (size_t)qq * 8192;
            unsigned kv[128];
            { int ne = nkeys >> 6; asm volatile("" : "+s"(ne));
#pragma unroll
            for (int g = 0; g < 4; ++g) {
                if (32 * g < ne) {
                    f32x4 tv[8];
#pragma unroll
                    for (int i = 0; i < 8; ++i) tv[i] = ld4(sbase + (8 * g + i) * 256 + lane * 4);
#pragma unroll
                    for (int i = 0; i < 8; ++i)
#pragma unroll
                        for (int j = 0; j < 4; ++j) { const int e = 32 * g + 4 * i + j; kv[e] = (e < ne) ? (fkey(tv[i][j]) & 0xffff0000u) : 0u; }
                } else {
#pragma unroll
                    for (int i = 0; i < 32; ++i) kv[32 * g + i] = 0u;
                }
                __builtin_amdgcn_sched_barrier(0);
            } }
            unsigned prefix = 0u, pmask = 0u; int krem = 256;
#pragma nounroll
            for (int pass = 0; pass < 4; ++pass) {
                const int shift = 28 - 4 * pass;
                int ne = nkeys >> 6; asm volatile("" : "+s"(ne));
                { const unsigned z = ozero();
#pragma unroll
                  for (int b = 0; b < 16; ++b) hist[b * 64 + lane] = z; }
#pragma unroll
                for (int g = 0; g < 8; ++g) if (16 * g < ne) {
#pragma unroll
                    for (int i = 0; i < 16; ++i) { const unsigned k = kv[16 * g + i];
                        __hip_atomic_fetch_add(&hist[((k >> shift) & 15u) * 64 + lane], ((k & pmask) == prefix) ? 1u : 0u, __ATOMIC_RELAXED, __HIP_MEMORY_SCOPE_WORKGROUP); } }
                int sum = 0;
                { const LAS u32x4* hp = (const LAS u32x4*)(hist + (lane & 15) * 64 + (lane >> 4) * 16);
#pragma unroll
                  for (int i = 0; i < 4; ++i) { const u32x4 v = hp[i]; sum += (int)(v.x + v.y + v.z + v.w); } }
                sum += __shfl_xor(sum, 16); sum += __shfl_xor(sum, 32);
                int incl = sum;
#pragma unroll
                for (int o = 1; o < 16; o <<= 1) { const int tt = __shfl_down(incl, o); if ((lane & 15) + o < 16) incl += tt; }
                const int excl = incl - sum;
                const bool hit = (lane < 16) && (excl < krem) && (krem <= incl);
                const u64 bal = __ballot(hit); const int src = bal ? (int)__builtin_ctzll(bal) : 0;
                const int ex = __shfl(excl, src);
                prefix |= ((unsigned)src) << shift; pmask |= 15u << shift; krem -= ex;
            }
            int run = 0, zcut = nkeys - 1; bool found = false;
            int ne = nkeys >> 6; asm volatile("" : "+s"(ne));
#pragma unroll
            for (int e = 0; e < 128; ++e) if (e < ne) {
                const bool eq = kv[e] == prefix; const u64 bal = __ballot(eq); const int cnt = __builtin_popcountll(bal);
                if (!found && run + cnt >= krem) { const int need = krem - run; const int below = (int)__builtin_amdgcn_mbcnt_hi((unsigned)(bal >> 32), __builtin_amdgcn_mbcnt_lo((unsigned)bal, 0u)) + 1;
                    const bool me = eq && (below == need); const u64 b2 = __ballot(me); zcut = e * 64 + (b2 ? (int)__builtin_ctzll(b2) : 63); found = true; }
                run += cnt;
                __builtin_amdgcn_sched_barrier(0);
            }
            asm volatile("" : "+s"(ne));
            const int zc = __builtin_amdgcn_readfirstlane(zcut), zw = zc >> 6, zb = zc & 63;
#pragma unroll
            for (int e = 0; e < 128; ++e) if (e < ne) { const unsigned k = kv[e]; const bool tie_ok = (e < zw) ? true : ((e == zw) ? (lane <= zb) : false); const bool sel = (k > prefix) || (k == prefix && tie_ok);
                const u64 bal = __ballot(sel); if (lane == 0) MASK[(size_t)(row0 + qq) * 128 + e] = bal; __builtin_amdgcn_sched_barrier(0); }
        }
        __syncthreads();
    }
}

__device__ __forceinline__ void phase_dsa_attn(LAS unsigned char* lds, const bf16_t* PD, const bf16_t* Kc, const bf16_t* Vc, const u64* MASK, bf16_t* YC, int tid) {
    const int wave = __builtin_amdgcn_readfirstlane(tid >> 6), lane = tid & 63, l15 = lane & 15, quad = lane >> 4;
    const int G = gridDim.x, bid = blockIdx.x;
    const int kp = tid >> 3, sseg = tid & 7;
    for (int it = 0;; ++it) {
        const int uo = it * G + ((it & 1) ? (G - 1 - bid) : bid);
        if (uo >= 2048) break;
        const int qb = 63 - (uo >> 5), bh = uo & 31, b = bh >> 3, head = bh & 7;
        const int row0 = b * 8192 + qb * 128 + wave * 16, nst = qb + 1, qchunk = 2 * qb + (wave >> 2);
        bf16x8 qf[2];
#pragma unroll
        for (int ks = 0; ks < 2; ++ks) { float qv[8]; unpack8(*(const u32x4*)(PD + (size_t)(row0 + l15) * PD_LD + head * 64 + ks * 32 + quad * 8), qv);
#pragma unroll
            for (int j = 0; j < 8; ++j) qv[j] *= 0.18033688011112042f;
            qf[ks] = pack8(qv); }
        float mrun = -1e30f, lrun = 0.f; f32x4 o[4];
#pragma unroll
        for (int dt = 0; dt < 4; ++dt) o[dt] = (f32x4){0.f, 0.f, 0.f, 0.f};
        const size_t kvo = ((size_t)((b * 8 + head) * 8192) + 2 * kp) * 64 + sseg * 8;
        const bf16_t* kcp = Kc + kvo; const bf16_t* vcp = Vc + kvo;
        u32x4 kreg0 = *(const u32x4*)kcp, vreg0 = *(const u32x4*)vcp, kreg1 = *(const u32x4*)(kcp + 64), vreg1 = *(const u32x4*)(vcp + 64);
        const u64* mrow = MASK + (size_t)(row0 + l15) * 128;
        u64 mn0 = mrow[0], mn1 = (1 <= qchunk) ? mrow[1] : 0ull;
        __syncthreads();
            { LAS bf16_t* Ks = (LAS bf16_t*)lds + (0) * 17920; LAS bf16_t* Vt = Ks + 128 * 72;
            *(LAS u32x4*)(Ks + (2 * kp) * 72 + sseg * 8) = kreg0; *(LAS u32x4*)(Ks + (2 * kp + 1) * 72 + sseg * 8) = kreg1;
            { const unsigned va[4] = {vreg0.x, vreg0.y, vreg0.z, vreg0.w}, vb[4] = {vreg1.x, vreg1.y, vreg1.z, vreg1.w};
              LAS unsigned* vtw = (LAS unsigned*)Vt + (sseg * 8) * 68 + (kp ^ (((sseg >> 1) & 3) << 3));
#pragma unroll
              for (int e = 0; e < 4; ++e) { vtw[(2 * e) * 68] = (va[e] & 0xffffu) | (vb[e] << 16); vtw[(2 * e + 1) * 68] = (va[e] >> 16) | (vb[e] & 0xffff0000u); } }
            }
        __syncthreads();
        for (int st = 0; st < nst; ++st) {
            const LAS bf16_t* Ks = (const LAS bf16_t*)lds + (st & 1) * 17920; const LAS bf16_t* Vt = Ks + 128 * 72;
            const u64 mw0 = mn0, mw1 = mn1;
            if (st + 1 < nst) { const size_t no = (size_t)(st + 1) * 128 * 64; kreg0 = *(const u32x4*)(kcp + no); vreg0 = *(const u32x4*)(vcp + no); kreg1 = *(const u32x4*)(kcp + no + 64); vreg1 = *(const u32x4*)(vcp + no + 64);
                mn0 = mrow[2 * st + 2]; mn1 = (2 * st + 3 <= qchunk) ? mrow[2 * st + 3] : 0ull; }
            f32x4 acc[8];
#pragma unroll
            for (int mt = 0; mt < 8; ++mt) { acc[mt] = (f32x4){0.f, 0.f, 0.f, 0.f};
#pragma unroll
                for (int ks = 0; ks < 2; ++ks) { const bf16x8 a = *(const LAS bf16x8*)(Ks + (16 * mt + l15) * 72 + ks * 32 + quad * 8); acc[mt] = MFMA16(a, qf[ks], acc[mt]); } }
            const unsigned mb[4] = {(unsigned)(mw0 >> (4 * quad)), (unsigned)(mw0 >> (32 + 4 * quad)), (unsigned)(mw1 >> (4 * quad)), (unsigned)(mw1 >> (32 + 4 * quad))};
            float tmax = -1e30f;
#pragma unroll
            for (int mt = 0; mt < 8; ++mt)
#pragma unroll
                for (int r = 0; r < 4; ++r) { const bool sel = ((mb[mt >> 1] >> (16 * (mt & 1) + r)) & 1u) != 0u; acc[mt][r] = sel ? acc[mt][r] : -1e30f; tmax = fmaxf(tmax, acc[mt][r]); }
            tmax = fmaxf(tmax, __shfl_xor(tmax, 16)); tmax = fmaxf(tmax, __shfl_xor(tmax, 32));
            const float mnew = fmaxf(mrun, tmax), alpha = __builtin_amdgcn_exp2f(mrun - mnew), meff = fmaxf(mnew, -1e29f);
            float psum = 0.f;
#pragma unroll
            for (int mt = 0; mt < 8; ++mt)
#pragma unroll
                for (int r = 0; r < 4; ++r) { const float p = __builtin_amdgcn_exp2f(acc[mt][r] - meff); acc[mt][r] = p; psum += p; }
            lrun = lrun * alpha + psum; mrun = mnew;
            bf16x8 pb[4];
#pragma unroll
            for (int k2 = 0; k2 < 4; ++k2) { u32x4 w; w.x = pg8::cvt_pk_bf16(acc[2 * k2][0], acc[2 * k2][1]); w.y = pg8::cvt_pk_bf16(acc[2 * k2][2], acc[2 * k2][3]); w.z = pg8::cvt_pk_bf16(acc[2 * k2 + 1][0], acc[2 * k2 + 1][1]); w.w = pg8::cvt_pk_bf16(acc[2 * k2 + 1][2], acc[2 * k2 + 1][3]);
                pb[k2] = __builtin_bit_cast(bf16x8, w); }
#pragma unroll
            for (int dt = 0; dt < 4; ++dt) { o[dt] = o[dt] * alpha;
#pragma unroll
                for (int k2 = 0; k2 < 4; ++k2) { const LAS unsigned* vr = (const LAS unsigned*)Vt + l15 * 68 + 2 * quad;
                    const u32x2 lo = *(const LAS u32x2*)(vr + 16 * dt * 68 + ((16 * k2) ^ (dt << 3))), hi = *(const LAS u32x2*)(vr + 16 * dt * 68 + ((16 * k2 + 8) ^ (dt << 3)));
                    u32x4 w; w.x = lo.x; w.y = lo.y; w.z = hi.x; w.w = hi.y;
                    o[dt] = MFMA16(__builtin_bit_cast(bf16x8, w), pb[k2], o[dt]); } }
            if (st + 1 < nst) {
                { LAS bf16_t* Ks = (LAS bf16_t*)lds + ((st + 1) & 1) * 17920; LAS bf16_t* Vt = Ks + 128 * 72;
                *(LAS u32x4*)(Ks + (2 * kp) * 72 + sseg * 8) = kreg0; *(LAS u32x4*)(Ks + (2 * kp + 1) * 72 + sseg * 8) = kreg1;
                { const unsigned va[4] = {vreg0.x, vreg0.y, vreg0.z, vreg0.w}, vb[4] = {vreg1.x, vreg1.y, vreg1.z, vreg1.w};
                  LAS unsigned* vtw = (LAS unsigned*)Vt + (sseg * 8) * 68 + (kp ^ (((sseg >> 1) & 3) << 3));
#pragma unroll
                  for (int e = 0; e < 4; ++e) { vtw[(2 * e) * 68] = (va[e] & 0xffffu) | (vb[e] << 16); vtw[(2 * e + 1) * 68] = (va[e] >> 16) | (vb[e] & 0xffff0000u); } }
                }
            }
            __syncthreads();
        }
        lrun += __shfl_xor(lrun, 16); lrun += __shfl_xor(lrun, 32);
        const float il = 1.f / lrun;
#pragma unroll
        for (int dt = 0; dt < 4; ++dt) { u32x2 w; w.x = pk2(o[dt][0] * il, o[dt][1] * il); w.y = pk2(o[dt][2] * il, o[dt][3] * il);
            *(u32x2*)(YC + (size_t)(row0 + l15) * 1024 + 512 + head * 64 + 16 * dt + 4 * quad) = w; }
    }
}

struct RwPar { const float *mu, *w0, *a0, *k_k, *k_a, *r_k, *gn_g, *gn_b; };

__device__ __forceinline__ void phase_rw_prep(const bf16_t* PR, const bf16_t* SM, const RwPar rp, bf16_t* E, bf16_t* A, bf16_t* Gt, int tid) {
    const int wave = __builtin_amdgcn_readfirstlane(tid >> 6), lane = tid & 63, l15 = lane & 15, quad = lane >> 4;
    const bf16_t* W2T = SM; const bf16_t* A2T = SM + 32768; const bf16_t* G2T = SM + 65536;
    for (int uid = blockIdx.x * 8 + wave; uid < 2048; uid += gridDim.x * 8) {
        const int row = uid * 16 + l15; const bool hasprev = (row & 8191) != 0;
        bf16x8 fw[2], fa[2], fg[4];
#pragma unroll
        for (int ks = 0; ks < 8; ++ks) {
            const int c0 = 1536 + ks * 32 + quad * 8; float p[8], q[8];
            unpack8(*(const u32x4*)(PR + (size_t)row * PR_LD + c0), p);
            if (hasprev) unpack8(*(const u32x4*)(PR + (size_t)(row - 1) * PR_LD + c0), q); else {
#pragma unroll
                for (int j = 0; j < 8; ++j) q[j] = 0.f; }
#pragma unroll
            for (int j = 0; j < 8; ++j) { float v = p[j] + (q[j] - p[j]) * rp.mu[c0 + j];
                if (ks < 2) { const float e2 = __expf(-2.f * fabsf(v)); const float th = (1.f - e2) / (1.f + e2); v = v < 0.f ? -th : th; } else if (ks >= 4) v = 1.f / (1.f + __expf(-v));
                p[j] = v; }
            const bf16x8 fr = pack8(p);
            if (ks < 2) fw[ks] = fr; else if (ks < 4) fa[ks - 2] = fr; else fg[ks - 4] = fr;
        }
        for (int nt = 0; nt < 32; ++nt) {
            const int cw = 16 * nt + l15;
            f32x4 aw = {0.f, 0.f, 0.f, 0.f}, aa = aw, ag = aw;
#pragma unroll
            for (int ks = 0; ks < 2; ++ks) { aw = MFMA16(*(const bf16x8*)(W2T + cw * 64 + ks * 32 + quad * 8), fw[ks], aw); aa = MFMA16(*(const bf16x8*)(A2T + cw * 64 + ks * 32 + quad * 8), fa[ks], aa); }
#pragma unroll
            for (int ks = 0; ks < 4; ++ks) ag = MFMA16(*(const bf16x8*)(G2T + cw * 128 + ks * 32 + quad * 8), fg[ks], ag);
            const int c = 16 * nt + 4 * quad; float e[4], a[4];
#pragma unroll
            for (int r = 0; r < 4; ++r) { const float lw = rp.w0[c + r] + aw[r]; const float x = -lw;
                const float sp = fmaxf(x, 0.f) + __logf(1.f + __expf(-fabsf(x)));
                e[r] = __expf(-sp - 0.5f); a[r] = 1.f / (1.f + __expf(-(rp.a0[c + r] + aa[r]))); }
            const size_t o = (size_t)row * 512 + c;
            u32x2 w; w.x = pk2(e[0], e[1]); w.y = pk2(e[2], e[3]); *(u32x2*)(E + o) = w;
            w.x = pk2(a[0], a[1]); w.y = pk2(a[2], a[3]); *(u32x2*)(A + o) = w;
            w.x = pk2(ag[0], ag[1]); w.y = pk2(ag[2], ag[3]); *(u32x2*)(Gt + o) = w;
        }
    }
}

__device__ __forceinline__ void phase_rw_scan(LAS unsigned char* lds, const bf16_t* PR, const bf16_t* E, const bf16_t* A, const RwPar rp, bf16_t* QP, bf16_t* OU, float* PU, int tid) {
    const int wave = __builtin_amdgcn_readfirstlane(tid >> 6), lane = tid & 63, pairi = wave >> 1, wsub = wave & 1, half = lane >> 5, ri = lane & 31;
    LAS float* vec = (LAS float*)lds + pairi * 3104;
    LAS float* vv = vec + 2560; LAS float* cs = vv + 512;
    const int irow = 32 * wsub + ri;
    for (int uid = blockIdx.x * 4 + pairi; uid < 1024; uid += gridDim.x * 4) {
        const int chunk = uid & 31, bh = uid >> 5, h = bh & 7, b = bh >> 3;
        const int col = h * 64 + lane;
        const float mur = rp.mu[col], muk = rp.mu[512 + col], muv = rp.mu[1024 + col], kk_ = rp.k_k[col], ka_ = rp.k_a[col];
        float SU[32], SP[32];
        int dsel = irow - 32 * half; asm volatile("" : "+v"(dsel));
#pragma unroll
        for (int j = 0; j < 32; ++j) { SU[j] = 0.f; SP[j] = (j == dsel) ? 1.f : 0.f; }
        const int tbase = chunk * 256;
        unsigned raw[4][4];
#define RW_LOAD_RAW(SUB) do { _Pragma("unroll") for (int s4 = 0; s4 < 4; ++s4) { const int t = tbase + (SUB) * 8 + 4 * wsub + s4; const size_t row = (size_t)b * 8192 + t; \
            const bf16_t* pr = PR + row * PR_LD + col; const bf16_t* pq = (t > 0) ? pr - PR_LD : pr; const unsigned pm = (t > 0) ? 0xffffffffu : 0x0000ffffu; \
            raw[s4][0] = ((unsigned)pr[0] | ((unsigned)pq[0] << 16)) & pm; raw[s4][1] = ((unsigned)pr[512] | ((unsigned)pq[512] << 16)) & pm; raw[s4][2] = ((unsigned)pr[1024] | ((unsigned)pq[1024] << 16)) & pm; \
            raw[s4][3] = (unsigned)E[row * 512 + col] | ((unsigned)A[row * 512 + col] << 16); } } while (0)
        RW_LOAD_RAW(0);
#pragma nounroll
        for (int sub = 0; sub < 32; ++sub) {
            __syncthreads();
#pragma unroll
            for (int s4 = 0; s4 < 4; ++s4) {
                const int s = 4 * wsub + s4;
                float r = bf2f(raw[s4][0] & 0xffffu), k = bf2f(raw[s4][1] & 0xffffu), v = bf2f(raw[s4][2] & 0xffffu);
                const float rq = bf2f(raw[s4][0] >> 16), kq = bf2f(raw[s4][1] >> 16), vq = bf2f(raw[s4][2] >> 16);
                r += (rq - r) * mur; k += (kq - k) * muk; v += (vq - v) * muv;
                const float e = bf2f(raw[s4][3] & 0xffffu), a = bf2f(raw[s4][3] >> 16);
                const float w = __expf(-e);
                const float kr = k * kk_; const float kp = k * (1.f + (a - 1.f) * ka_);
                const float n2 = wave_sum(kr * kr), c1r = wave_sum(kr * a * r), c2 = wave_sum(kp * r);
                const float inrm = 1.f / fmaxf(sqrtf(n2), 1e-12f);
                const float kn = kr * inrm, kka = kn * a, c1 = c1r * inrm;
                LAS float* vs = vec + s * 320;
                vs[lane] = -kn; vs[64 + lane] = w * r; vs[128 + lane] = w; vs[192 + lane] = kka; vs[256 + lane] = kp;
                vv[s * 64 + lane] = v;
                if (lane == 0) { cs[2 * s] = c1; cs[2 * s + 1] = c2; }
            }
            __syncthreads();
            if (sub + 1 < 32) RW_LOAD_RAW(sub + 1);
#pragma nounroll
            for (int s = 0; s < 8; ++s) {
                const LAS float* vs = vec + s * 320 + 32 * half;
                float saU = 0.f, saP = 0.f, oU = 0.f, oP = 0.f;
#pragma unroll
                for (int j4 = 0; j4 < 8; ++j4) { const f32x4 nk = *(const LAS f32x4*)(vs + 4 * j4), wr = *(const LAS f32x4*)(vs + 64 + 4 * j4);
#pragma unroll
                    for (int q = 0; q < 4; ++q) { const int j = 4 * j4 + q; saU += SU[j] * nk[q]; saP += SP[j] * nk[q]; oU += SU[j] * wr[q]; oP += SP[j] * wr[q]; }
                    __builtin_amdgcn_sched_barrier(0); }
                saU += __shfl_xor(saU, 32); saP += __shfl_xor(saP, 32); oU += __shfl_xor(oU, 32); oP += __shfl_xor(oP, 32);
                const float vi = vv[s * 64 + irow], c1 = cs[2 * s], c2 = cs[2 * s + 1];
#pragma unroll
                for (int j4 = 0; j4 < 8; ++j4) { const f32x4 w4 = *(const LAS f32x4*)(vs + 128 + 4 * j4), ka4 = *(const LAS f32x4*)(vs + 192 + 4 * j4), kp4 = *(const LAS f32x4*)(vs + 256 + 4 * j4);
#pragma unroll
                    for (int q = 0; q < 4; ++q) { const int j = 4 * j4 + q; SU[j] = SU[j] * w4[q] + saU * ka4[q] + vi * kp4[q]; SP[j] = SP[j] * w4[q] + saP * ka4[q]; }
                    __builtin_amdgcn_sched_barrier(0); }
                const size_t o = ((size_t)b * 8192 + tbase + sub * 8 + s) * 512 + h * 64 + irow;
                if (half == 0) OU[o] = (bf16_t)f2bf(oU + saU * c1 + vi * c2);
                else QP[o] = (bf16_t)f2bf(oP + saP * c1);
            }
        }
#undef RW_LOAD_RAW
        float* pu = PU + (size_t)uid * 8192 + irow * 64 + 32 * half;
#pragma unroll
        for (int j4 = 0; j4 < 8; ++j4) { *(f32x4*)(pu + 4 * j4) = (f32x4){SP[4 * j4], SP[4 * j4 + 1], SP[4 * j4 + 2], SP[4 * j4 + 3]};
            *(f32x4*)(pu + 4096 + 4 * j4) = (f32x4){SU[4 * j4], SU[4 * j4 + 1], SU[4 * j4 + 2], SU[4 * j4 + 3]}; }
    }
}

__device__ __forceinline__ void phase_rw_combine(LAS unsigned char* lds, const float* PU, float* SINIT, int tid) {
    const int wave = __builtin_amdgcn_readfirstlane(tid >> 6), lane = tid & 63;
    LAS float* sl = (LAS float*)lds + wave * 512;
    LAS float* Pl = (LAS float*)lds + 4096;
    for (int bh = blockIdx.x; bh < 32; bh += gridDim.x) {
        float s[8], un[8];
#pragma unroll
        for (int r = 0; r < 8; ++r) s[r] = 0.f;
        const float* P0 = PU + (size_t)(bh * 32) * 8192;
        f32x4 r0 = ld4(P0 + 4 * tid), r1 = ld4(P0 + 2048 + 4 * tid);
#pragma unroll
        for (int r = 0; r < 8; ++r) un[r] = P0[4096 + (wave * 8 + r) * 64 + lane];
        __syncthreads();
        *(LAS f32x4*)(Pl + 4 * tid) = r0; *(LAS f32x4*)(Pl + 2048 + 4 * tid) = r1;
        __syncthreads();
#pragma nounroll
        for (int c = 0; c < 32; ++c) {
            const int uid = bh * 32 + c;
            const LAS float* Pc = Pl + (c & 1) * 4096;
            float acc[8];
#pragma unroll
            for (int r = 0; r < 8; ++r) { SINIT[(size_t)uid * 4096 + (wave * 8 + r) * 64 + lane] = s[r]; sl[r * 64 + lane] = s[r]; acc[r] = un[r]; }
            const int cn = (c + 1 < 32) ? c + 1 : c;
            const float* Pn = PU + (size_t)(bh * 32 + cn) * 8192;
            r0 = ld4(Pn + 4 * tid); r1 = ld4(Pn + 2048 + 4 * tid);
#pragma unroll
            for (int r = 0; r < 8; ++r) un[r] = Pn[4096 + (wave * 8 + r) * 64 + lane];
            __builtin_amdgcn_wave_barrier();
#pragma unroll 4
            for (int j4 = 0; j4 < 16; ++j4) {
                const float p0 = Pc[(4 * j4) * 64 + lane], p1 = Pc[(4 * j4 + 1) * 64 + lane], p2 = Pc[(4 * j4 + 2) * 64 + lane], p3 = Pc[(4 * j4 + 3) * 64 + lane];
#pragma unroll
                for (int r = 0; r < 8; ++r) { const f32x4 sv = *(const LAS f32x4*)(sl + r * 64 + 4 * j4); acc[r] += sv[0] * p0 + sv[1] * p1 + sv[2] * p2 + sv[3] * p3; }
            }
#pragma unroll
            for (int r = 0; r < 8; ++r) s[r] = acc[r];
            LAS float* Pw = Pl + ((c + 1) & 1) * 4096;
            *(LAS f32x4*)(Pw + 4 * tid) = r0; *(LAS f32x4*)(Pw + 2048 + 4 * tid) = r1;
            __syncthreads();
        }
    }
}

__device__ __forceinline__ void phase_rw_out(LAS unsigned char* lds, const bf16_t* PR, const bf16_t* A, const bf16_t* Gt, const bf16_t* QP, const bf16_t* OU, const float* SINIT, const RwPar rp, bf16_t* YC, int tid) {
    const int wave = __builtin_amdgcn_readfirstlane(tid >> 6), lane = tid & 63;
    LAS float* qs = (LAS float*)lds + wave * 1024;
    for (int uid = blockIdx.x * 8 + wave; uid < 2048; uid += gridDim.x * 8) {
        const int chunk = uid & 63, bh = uid >> 6, h = bh & 7, b = bh >> 3;
        const int col = h * 64 + lane;
        const float mur = rp.mu[col], muk = rp.mu[512 + col], muv = rp.mu[1024 + col], ka_ = rp.k_a[col], rk_ = rp.r_k[col], gg = rp.gn_g[col], gb = rp.gn_b[col];
        float S[64];
        const float* sp = SINIT + (size_t)(bh * 32 + (chunk >> 1)) * 4096 + lane * 64;
#pragma unroll
        for (int j4 = 0; j4 < 16; ++j4) { const f32x4 v = ld4(sp + 4 * j4); S[4 * j4] = v[0]; S[4 * j4 + 1] = v[1]; S[4 * j4 + 2] = v[2]; S[4 * j4 + 3] = v[3]; }
        for (int sub = 0; sub < 8; ++sub) {
            const size_t rbase = (size_t)b * 8192 + chunk * 128 + sub * 16;
#pragma unroll
            for (int s = 0; s < 16; ++s) qs[s * 64 + lane] = bf2f(QP[(rbase + s) * 512 + col]);
            __builtin_amdgcn_wave_barrier();
#pragma unroll 4
            for (int s = 0; s < 16; ++s) {
                const size_t row = rbase + s; const int t = (int)(row & 8191);
                float o = bf2f(OU[row * 512 + col]);
#pragma unroll
                for (int j4 = 0; j4 < 16; ++j4) { const f32x4 q = *(const LAS f32x4*)(qs + s * 64 + 4 * j4); o += S[4 * j4] * q[0] + S[4 * j4 + 1] * q[1] + S[4 * j4 + 2] * q[2] + S[4 * j4 + 3] * q[3]; }
                const bf16_t* pr = PR + row * PR_LD + col;
                float r = bf2f(pr[0]), k = bf2f(pr[512]), v = bf2f(pr[1024]);
                float rq = 0.f, kq = 0.f, vq = 0.f;
                if (t > 0) { rq = bf2f(pr[-PR_LD]); kq = bf2f(pr[512 - PR_LD]); vq = bf2f(pr[1024 - PR_LD]); }
                r += (rq - r) * mur; k += (kq - k) * muk; v += (vq - v) * muv;
                const float a = bf2f(A[row * 512 + col]);
                const float kp = k * (1.f + (a - 1.f) * ka_);
                const float s1 = wave_sum(o), s2 = wave_sum(o * o), bsum = wave_sum(r * kp * rk_);
                const float mean = s1 * (1.f / 64.f), d = o - mean, var = fmaxf(s2 * (1.f / 64.f) - mean * mean, 0.f);
                const float on = d * (1.f / sqrtf(var + GN_EPS)) * gg + gb;
                const float g = bf2f(Gt[row * 512 + col]);
                YC[row * 1024 + col] = (bf16_t)f2bf((on + bsum * v) * g);
            }
            __builtin_amdgcn_wave_barrier();
        }
    }
}

struct Args { const float* in[33]; float* out; unsigned char* ws; int ph_lo, ph_hi; };
enum { P_MOD = 0, P_CVT0, P_GIN_E, P_DPREP, P_DSEL, P_DATTN, P_RPREP, P_RSCAN, P_RCOMB, P_ROUT, P_GIN_O, P_ODDMIX, P_GOUT, P_LN1, P_GUP, P_FIX, P_GDN, P_LN2, P_COUNT };

template <int P, bool TAB>
__device__ __forceinline__ void run_phase(const Args& args, LAS unsigned char* lds, const int l, const int wv) {
#define otid() otid_(wv)
#define TABP(k) ({ unsigned a_ = TAB_OFF + 8 * (k); asm volatile("" : "+s"(a_)); const u64 v_ = *(volatile LAS u64*)(lds + a_); const unsigned lo_ = __builtin_amdgcn_readfirstlane((unsigned)v_), hi_ = __builtin_amdgcn_readfirstlane((unsigned)(v_ >> 32)); (((u64)hi_) << 32) | lo_; })
#define IN(k) (TAB ? (const float*)TABP(k) : args.in[k])
#define ws (TAB ? (unsigned char*)TABP(34) : args.ws)
#define X (TAB ? (float*)TABP(33) : args.out)
#define MOD ((float*)(ws + WS_MOD))
#define H ((bf16_t*)(ws + WS_H))
#define YC ((bf16_t*)(ws + WS_YC))
#define PR ((bf16_t*)(ws + WS_PR))
#define PD ((bf16_t*)(ws + WS_PD))
#define WIN ((bf16_t*)(ws + WS_WIN))
#define WOUT ((bf16_t*)(ws + WS_WOUT))
#define WUP ((bf16_t*)(ws + WS_WUP))
#define WDN ((bf16_t*)(ws + WS_WDN))
#define SM ((bf16_t*)(ws + WS_SMALL))
#define HID ((bf16_t*)(ws + WS_HID))
#define SIDE ((float*)(ws + WS_SIDE))
#define x_in IN(0)
#define CVT_PTRS(l) CvtPtrs{ ((l) & 1) ? IN(25) + (size_t)((l) >> 1) * 1024 * ODD_COLS : IN(10) + (size_t)((l) >> 1) * 1024 * EVEN_COLS, \
                             ((l) & 1) ? IN(26) + (size_t)((l) >> 1) * 1048576 : IN(11) + (size_t)((l) >> 1) * 1048576, \
                             IN(6) + (size_t)(l) * 1024 * 5632, IN(9) + (size_t)(l) * 2816 * 1024, \
                             ((l) & 1) ? IN(27) + (size_t)((l) >> 1) * 65536 : IN(14) + (size_t)((l) >> 1) * 32768, \
                             ((l) & 1) ? IN(31) + (size_t)((l) >> 1) * 65536 : IN(16) + (size_t)((l) >> 1) * 32768, \
                             ((l) & 1) ? nullptr : IN(17) + (size_t)((l) >> 1) * 65536 }
#define modl (MOD + (size_t)l * 4 * 6144)
#define xsrc ((l == 0) ? x_in : X)
#define rp (RwPar{IN(12) + e * 1792, IN(13) + e * 512, IN(15) + e * 512, IN(18) + e * 512, IN(19) + e * 512, IN(20) + e * 512, IN(21) + e * 512, IN(22) + e * 512})
#define Eb ((bf16_t*)(ws + WS_E))
#define Ab ((bf16_t*)(ws + WS_A))
#define Gb ((bf16_t*)(ws + WS_G))
#define QP ((bf16_t*)(ws + WS_QP))
#define OU ((bf16_t*)(ws + WS_OU))
#define PU ((float*)(ws + WS_PU))
#define SI ((float*)(ws + WS_SINIT))
    const int e = l >> 1;
    if constexpr (P == P_MOD) phase_mod(lds, IN(1), IN(2), IN(3), MOD, otid());
    if constexpr (P == P_CVT0) { phase_convert(lds, ws, CVT_PTRS(0), true, otid()); phase_h0(x_in, MOD, H, otid()); phase_rope_table((float*)(ws + WS_ROPE), otid()); }
    if constexpr (P == P_GIN_E) { pg8::Gemm g{H, WIN, M, EVEN_PAD, D}; pg8::StaticOrder S; S.init(M, EVEN_PAD, gridDim.x, blockIdx.x);
        pg8::EpiStoreP E{PR, PR_LD, 7, PD, PD_LD};
        pg8::gemm_phase<pg8::EpiStoreP, pg8::StaticOrder, true, true>(lds, g, S, E, otid()); }
    if constexpr (P == P_DPREP) phase_dsa_prep(PD, IN(23) + e * 64, IN(24) + e * 64, (const float*)(ws + WS_ROPE), (bf16_t*)(ws + WS_KC), (bf16_t*)(ws + WS_VC), (bf16_t*)(ws + WS_KI), otid());
    if constexpr (P == P_DSEL) { float* scr = (float*)(ws + ((blockIdx.x < 128) ? WS_SCRA + (size_t)blockIdx.x * 524288 : WS_SCRB + (size_t)(blockIdx.x - 128) * 524288));
        phase_dsa_select(lds, PD, (const bf16_t*)(ws + WS_KI), scr, (u64*)(ws + WS_MASK), otid()); }
    if constexpr (P == P_DATTN) phase_dsa_attn(lds, PD, (const bf16_t*)(ws + WS_KC), (const bf16_t*)(ws + WS_VC), (const u64*)(ws + WS_MASK), YC, otid());
    if constexpr (P == P_RPREP) phase_rw_prep(PR, SM, rp, Eb, Ab, Gb, otid());
    if constexpr (P == P_RSCAN) phase_rw_scan(lds, PR, Eb, Ab, rp, QP, OU, PU, otid());
    if constexpr (P == P_RCOMB) phase_rw_combine(lds, PU, SI, otid());
    if constexpr (P == P_ROUT) phase_rw_out(lds, PR, Ab, Gb, QP, OU, SI, rp, YC, otid());
    if constexpr (P == P_GIN_O) { pg8::Gemm g{H, WIN, M, ODD_COLS, D}; pg8::StaticOrder S; S.init(M, ODD_COLS, gridDim.x, blockIdx.x);
        pg8::EpiStoreP E{PR, ODD_COLS, 6, PR, ODD_COLS};
        pg8::gemm_phase<pg8::EpiStoreP, pg8::StaticOrder, true, true>(lds, g, S, E, otid()); }
    if constexpr (P == P_ODDMIX) { phase_pool(PR, SM + 131072, IN(28) + e * 512, YC, otid());
        phase_sgu(lds, PR, SM + 196608, IN(29) + e * 512, IN(30) + e * 512, IN(32) + e * 512, YC, otid()); }
    if constexpr (P == P_GOUT) { pg8::Gemm g{YC, WOUT, M, D, D}; pg8::StaticOrder S; S.init(M, D, gridDim.x, blockIdx.x);
        pg8::EpiResid E{xsrc, X, modl + 2 * 1024};
        pg8::gemm_phase<pg8::EpiResid, pg8::StaticOrder, true, true>(lds, g, S, E, otid()); }
    if constexpr (P == P_LN1) phase_ln(X, IN(4) + (size_t)(l * 2) * 1024, IN(5) + (size_t)(l * 2) * 1024, modl + 3 * 1024, H, otid());
    if constexpr (P == P_GUP) { pg8::Gemm g{H, WUP, M, DFF2, D}; pg8::StaticOrder S; S.init(M, DFF2, gridDim.x, blockIdx.x);
        pg8::EpiFFN E{HID, SIDE, IN(7) + (size_t)l * 3 * 5632, IN(8) + (size_t)l * 5632};
        pg8::gemm_phase<pg8::EpiFFN, pg8::StaticOrder, true, true>(lds, g, S, E, otid()); }
    if constexpr (P == P_FIX) phase_ffn_fix(SIDE, IN(7) + (size_t)l * 3 * 5632, IN(8) + (size_t)l * 5632, HID, otid());
    if constexpr (P == P_GDN) { pg8::Gemm g{HID, WDN, M, D, DFF}; pg8::StaticOrder S; S.init(M, D, gridDim.x, blockIdx.x);
        float* xx = X; pg8::EpiResid E{xx, xx, modl + 5 * 1024};
        pg8::gemm_phase<pg8::EpiResid, pg8::StaticOrder, true, true>(lds, g, S, E, otid()); }
    if constexpr (P == P_LN2) {
        phase_ln(X, IN(4) + (size_t)(l * 2 + 1) * 1024, IN(5) + (size_t)(l * 2 + 1) * 1024, (l < 3) ? (MOD + (size_t)(l + 1) * 4 * 6144) : nullptr, H, otid());
        if (l < 3) { if (l & 1) phase_convert(lds, ws, CVT_PTRS(l + 1), true, otid()); else phase_convert(lds, ws, CVT_PTRS(l + 1), false, otid()); }
    }
#undef otid
#undef TABP
#undef IN
#undef ws
#undef X
#undef MOD
#undef H
#undef YC
#undef PR
#undef PD
#undef WIN
#undef WOUT
#undef WUP
#undef WDN
#undef SM
#undef HID
#undef SIDE
#undef x_in
#undef CVT_PTRS
#undef modl
#undef xsrc
#undef rp
#undef Eb
#undef Ab
#undef Gb
#undef QP
#undef OU
#undef PU
#undef SI
}

template <int P>
__global__ void __launch_bounds__(NT, 2) phase_kernel(Args args, int l) {
    extern __shared__ __attribute__((aligned(16))) unsigned char lds_raw[];
    run_phase<P, false>(args, (LAS unsigned char*)lds_raw, l, __builtin_amdgcn_readfirstlane(threadIdx.x >> 6));
}

#ifndef MK_SINGLE
#define MK_SINGLE 1
#endif
#if MK_SINGLE
__global__ void __launch_bounds__(NT, 2) trunk_fwd(Args args) {
    extern __shared__ __attribute__((aligned(16))) unsigned char lds_raw[];
    LAS unsigned char* lds = (LAS unsigned char*)lds_raw;
    cg::grid_group grid = cg::this_grid();
    if (threadIdx.x < 33) ((LAS u64*)(lds + TAB_OFF))[threadIdx.x] = (u64)args.in[threadIdx.x];
    if (threadIdx.x == 33) ((LAS u64*)(lds + TAB_OFF))[33] = (u64)args.out;
    if (threadIdx.x == 34) ((LAS u64*)(lds + TAB_OFF))[34] = (u64)args.ws;
    if (threadIdx.x == 35) { ((LAS unsigned*)(lds + TAB_OFF + 512))[0] = 0u; ((LAS unsigned*)(lds + TAB_OFF + 512))[1] = 0u; }
    __syncthreads();
    const int wv = __builtin_amdgcn_readfirstlane(threadIdx.x >> 6);
#ifndef PROBE_MASK
#define PROBE_MASK 0
#endif
#define GSYNC() grid.sync()
#define PHASE(P, l) do { run_phase<P, true>(args, lds, (l), wv); GSYNC(); if ((PROBE_MASK >> P) & 1) { run_phase<P, true>(args, lds, (l), wv); GSYNC(); } } while (0)
    run_phase<P_MOD, true>(args, lds, 0, wv);
    grid.sync();
    PHASE(P_CVT0, 0);
#pragma nounroll
    for (int l = 0; l < 4; ++l) {
        if (!(l & 1)) { PHASE(P_GIN_E, l); PHASE(P_DPREP, l); PHASE(P_DSEL, l); PHASE(P_DATTN, l); PHASE(P_RPREP, l); PHASE(P_RSCAN, l); PHASE(P_RCOMB, l); PHASE(P_ROUT, l); }
        else { PHASE(P_GIN_O, l); PHASE(P_ODDMIX, l); }
        PHASE(P_GOUT, l); PHASE(P_LN1, l); PHASE(P_GUP, l); PHASE(P_FIX, l); PHASE(P_GDN, l);
        if (l < 3) PHASE(P_LN2, l); else run_phase<P_LN2, true>(args, lds, l, wv);
    }
#undef PHASE
#undef GSYNC
}
#endif
template <int P> static void launch_phase(const Args& a, int l, int grid, hipStream_t stream) {
    static bool attr_done = false;
    if (!attr_done) { (void)hipFuncSetAttribute((const void*)phase_kernel<P>, hipFuncAttributeMaxDynamicSharedMemorySize, LDS_BYTES); attr_done = true; }
    hipLaunchKernelGGL(phase_kernel<P>, dim3(grid), dim3(NT), LDS_BYTES, stream, a, l);
}

extern "C" void kernel_launch(void* const* d_in, const int* in_sizes, int n_in, void* d_out, int out_size, void* d_ws, size_t ws_size, hipStream_t stream) {
    static int grid = 0;
    if (grid == 0) {
        if (n_in != 33 || out_size != M * D || ws_size < WS_NEED) { fprintf(stderr, "kernel_launch: unexpected problem (n_in %d out %d ws %zu)\n", n_in, out_size, ws_size); grid = -1; return; }
        int dev = 0, cus = 0;
        (void)hipGetDevice(&dev); (void)hipDeviceGetAttribute(&cus, hipDeviceAttributeMultiprocessorCount, dev);
#if MK_SINGLE
        if (hipFuncSetAttribute((const void*)trunk_fwd, hipFuncAttributeMaxDynamicSharedMemorySize, LDS_BYTES) != hipSuccess) { fprintf(stderr, "kernel_launch: hipFuncSetAttribute failed\n"); grid = -1; return; }
#endif
        (void)hipGetLastError();
        grid = cus > 0 ? cus : 256;
    }
    if (grid < 0) return;
    Args a{};
    for (int i = 0; i < 33; ++i) a.in[i] = (const float*)d_in[i];
    a.out = (float*)d_out; a.ws = (unsigned char*)d_ws; a.ph_lo = 0; a.ph_hi = 1 << 20;
#if MK_SINGLE
    void* kargs[] = {&a};
    hipError_t er = hipLaunchCooperativeKernel((const void*)trunk_fwd, dim3(grid), dim3(NT), kargs, LDS_BYTES, stream);
    if (er != hipSuccess) fprintf(stderr, "kernel_launch: cooperative launch failed: %s\n", hipGetErrorString(er));
#else
    launch_phase<P_MOD>(a, 0, grid, stream); launch_phase<P_CVT0>(a, 0, grid, stream);
    for (int l = 0; l < 4; ++l) {
        if (!(l & 1)) { launch_phase<P_GIN_E>(a, l, grid, stream); launch_phase<P_DPREP>(a, l, grid, stream); launch_phase<P_DSEL>(a, l, grid, stream); launch_phase<P_DATTN>(a, l, grid, stream);
            launch_phase<P_RPREP>(a, l, grid, stream); launch_phase<P_RSCAN>(a, l, grid, stream); launch_phase<P_RCOMB>(a, l, grid, stream); launch_phase<P_ROUT>(a, l, grid, stream); }
        else { launch_phase<P_GIN_O>(a, l, grid, stream); launch_phase<P_ODDMIX>(a, l, grid, stream); }
        launch_phase<P_GOUT>(a, l, grid, stream); launch_phase<P_LN1>(a, l, grid, stream); launch_phase<P_GUP>(a, l, grid, stream); launch_phase<P_FIX>(a, l, grid, stream);
        launch_phase<P_GDN>(a, l, grid, stream); launch_phase<P_LN2>(a, l, grid, stream);
    }
#endif
}
```

```cpp
#include <hip/hip_runtime.h>
#include <hip/hip_cooperative_groups.h>
#include <cstdio>
#include <cstdint>
namespace cg = cooperative_groups;
namespace pg8 {
#define PG8_LAS __attribute__((address_space(3)))
typedef unsigned short bf16_t;
typedef short bf16x8 __attribute__((ext_vector_type(8)));
typedef float f32x4 __attribute__((ext_vector_type(4)));
typedef unsigned u32x4 __attribute__((ext_vector_type(4)));
constexpr int BM = 256, BK = 64, HALF = 128, HTB = HALF * BK * 2  , STAGE_BYTES = 8 * HTB, NXCD = 8, WGM = 8;

__host__ __device__ __forceinline__ int lds_byte(int r, int c) { const int st = (r >> 4) * 2 + (c >> 5), rr = r & 15, cc = c & 31, ob = rr * 64 + cc * 2; return st * 1024 + (ob ^ (((ob >> 9) & 1) << 5)); }
__host__ __device__ __forceinline__ void stage_rc(int b, int& R, int& C) { const int st = b / 1024, sb = b % 1024, swz = sb ^ (((sb >> 9) & 1) << 5); R = (st >> 1) * 16 + swz / 64; C = (st & 1) * 32 + (swz % 64) / 2; }
__host__ __device__ __forceinline__ int perm32(int rho) { const int n = rho >> 4, i = rho & 15; return 8 * (i >> 2) + 4 * n + (i & 3); }

struct Unit { int pm, pn; };
struct Gemm { const bf16_t* A; const bf16_t* Bt; int M, N, K; };

struct StaticOrder {
    int nM, nN, nwg, G, c;
    __host__ __device__ void init(int M, int N, int G_, int c_) { nM = M / BM; nN = N / BM; nwg = nM * nN; G = G_; c = c_; }
    __host__ __device__ bool next(int i, Unit& u) const {
        const long L = (long)i * G + c; if (L >= nwg) return false;
        int wgid = (int)L; { const int q = nwg / NXCD, r = nwg % NXCD, xcd = wgid % NXCD, off = wgid / NXCD; wgid = (xcd < r ? xcd * (q + 1) : r * (q + 1) + (xcd - r) * q) + off; }
        const int nig = WGM * nN, gid = wgid / nig, fm = gid * WGM, gsz = (nM - fm) < WGM ? (nM - fm) : WGM;
        u.pm = fm + ((wgid % nig) % gsz); u.pn = (wgid % nig) / gsz; return true;
    }
    __device__ __forceinline__ void a_ready(const Unit&) const {}
    __device__ __forceinline__ void done(const Unit&) const {}
};

__device__ __forceinline__ unsigned cvt_pk_bf16(float lo, float hi) { unsigned r; asm volatile("v_cvt_pk_bf16_f32 %0, %1, %2" : "=v"(r) : "v"(lo), "v"(hi)); return r; }
template <class Epi, class Sched, bool ALIGN_EPI = false, bool SP2 = false>
__device__ __forceinline__ void gemm_phase(PG8_LAS unsigned char* lds, const Gemm g, const Sched& S, const Epi& E, const int tid) {
    const int wid = __builtin_amdgcn_readfirstlane(tid >> 6), lane = tid & 63, wr = wid >> 2, wc = wid & 3, fr = lane & 15, fq = lane >> 4;
    const int K = g.K, nt = K / BK;
    unsigned voffA[2], voffB[2];
#pragma unroll
    for (int i = 0; i < 2; ++i) { int R, C; stage_rc(tid * 16 + i * 8192, R, C); const int Rb = Epi::PERM ? ((R & ~31) + perm32(R & 31)) : R;
        voffA[i] = (unsigned)(R * K + C) * 2u; voffB[i] = (unsigned)(Rb * K + C) * 2u; }
    const size_t kstep = (size_t)(BK * 2);
    const size_t hstep = (size_t)HALF * K * 2;
    const size_t tstep = 2 * hstep;
    const unsigned ldsw = (unsigned)wid * 1024u;
    const int aoff = lds_byte(wr * 64 + fr, fq * 8), boff = lds_byte(wc * 32 + fr, fq * 8);
#define PG8_SA(b, h) (((b) * 2 + (h)) * HTB)
#define PG8_SB(b, h) ((4 + (b) * 2 + (h)) * HTB)
#define PG8_STAGE(bufoff, gbase, voff) do { _Pragma("unroll") for (int _i = 0; _i < 2; ++_i) \
        __builtin_amdgcn_global_load_lds((const unsigned*)((const char*)(gbase) + (voff)[_i]), (PG8_LAS unsigned*)(lds + (bufoff) + ldsw + _i * 8192), 16, 0, 0); } while (0)
#define PG8_LDA(dst, b, h) do { _Pragma("unroll") for (int m = 0; m < 4; ++m) _Pragma("unroll") for (int k = 0; k < 2; ++k) dst[m][k] = *(const PG8_LAS bf16x8*)(lds + PG8_SA(b, h) + aoff + m * 2048 + k * 1024); } while (0)
#define PG8_LDB(dst, b, h) do { _Pragma("unroll") for (int n = 0; n < 2; ++n) _Pragma("unroll") for (int k = 0; k < 2; ++k) dst[n][k] = *(const PG8_LAS bf16x8*)(lds + PG8_SB(b, h) + boff + n * 2048 + k * 1024); } while (0)
#define PG8_MMA(ai, bj, At, Bt) do { __builtin_amdgcn_s_setprio(1); _Pragma("unroll") for (int m = 0; m < 4; ++m) _Pragma("unroll") for (int n = 0; n < 2; ++n) _Pragma("unroll") for (int k = 0; k < 2; ++k) \
        acc[ai][bj][m][n] = __builtin_amdgcn_mfma_f32_16x16x32_bf16(Bt[n][k], At[m][k], acc[ai][bj][m][n], 0, 0, 0); __builtin_amdgcn_s_setprio(0); } while (0)
#define PG8_WAIT_V(n) asm volatile("s_waitcnt vmcnt(" #n ")" ::: "memory")
#define PG8_WAIT_L(n) asm volatile("s_waitcnt lgkmcnt(" #n ")" ::: "memory")
#define PG8_BAR __builtin_amdgcn_s_barrier()
#define PG8_SCHED __builtin_amdgcn_sched_barrier(0)
    Unit cur, nxt; int ui = 0;
    if (!S.next(0, cur)) return;
    f32x4 acc[2][2][4][2];
#pragma unroll
    for (int a = 0; a < 2; ++a)
#pragma unroll
        for (int b = 0; b < 2; ++b)
#pragma unroll
            for (int m = 0; m < 4; ++m)
#pragma unroll
                for (int n = 0; n < 2; ++n) acc[a][b][m][n] = (f32x4){0.f, 0.f, 0.f, 0.f};
    bf16x8 At[4][2], B0[2][2], B1[2][2];
    const char* cA = (const char*)g.A + (size_t)cur.pm * tstep; const char* cB = (const char*)g.Bt + (size_t)cur.pn * tstep;
    S.a_ready(cur);
    if constexpr (SP2) {
        PG8_STAGE(PG8_SB(0, 0), cB, voffB); PG8_STAGE(PG8_SB(0, 1), cB + hstep, voffB); PG8_STAGE(PG8_SA(0, 0), cA, voffA); PG8_STAGE(PG8_SA(0, 1), cA + hstep, voffA);
        if (wr == 1) PG8_BAR;
        PG8_WAIT_V(2); PG8_BAR;
        PG8_STAGE(PG8_SB(1, 0), cB + kstep, voffB); PG8_STAGE(PG8_SA(1, 0), cA + kstep, voffA); PG8_STAGE(PG8_SB(1, 1), cB + hstep + kstep, voffB);
        PG8_WAIT_V(6); PG8_BAR;
    } else {
        PG8_STAGE(PG8_SB(0, 0), cB, voffB); PG8_STAGE(PG8_SA(0, 0), cA, voffA); PG8_STAGE(PG8_SB(0, 1), cB + hstep, voffB); PG8_STAGE(PG8_SA(0, 1), cA + hstep, voffA);
        if (wr == 1) PG8_BAR;
        PG8_WAIT_V(4); PG8_BAR;
        PG8_STAGE(PG8_SB(1, 0), cB + kstep, voffB); PG8_STAGE(PG8_SA(1, 0), cA + kstep, voffA); PG8_STAGE(PG8_SB(1, 1), cB + hstep + kstep, voffB);
        PG8_WAIT_V(6); PG8_BAR;
    }
    for (;;) {
        const bool has_next = S.next(ui + 1, nxt);
        const char* nA = has_next ? (const char*)g.A + (size_t)nxt.pm * tstep : cA; const char* nB = has_next ? (const char*)g.Bt + (size_t)nxt.pn * tstep : cB;
        for (int t = 0; t < nt; t += 2) {
            const bool last = (t == nt - 2);
            const char* a1 = cA + (size_t)(t + 1) * kstep;
            const char* a2 = last ? nA : cA + (size_t)(t + 2) * kstep; const char* b2 = last ? nB : cB + (size_t)(t + 2) * kstep;
            const char* a3 = a2 + kstep; const char* b3 = b2 + kstep;
            if (last && has_next) S.a_ready(nxt);
            if constexpr (SP2) {
            PG8_LDB(B0, 0, 0); PG8_LDB(B1, 0, 1); PG8_SCHED; PG8_LDA(At, 0, 0); PG8_STAGE(PG8_SA(1, 1), a1 + hstep, voffA);
            PG8_WAIT_V(8); PG8_WAIT_L(0); PG8_BAR; PG8_MMA(0, 0, At, B0); PG8_MMA(0, 1, At, B1); PG8_BAR; PG8_SCHED;
            PG8_LDA(At, 0, 1); PG8_STAGE(PG8_SB(0, 0), b2, voffB); PG8_STAGE(PG8_SB(0, 1), b2 + hstep, voffB); PG8_STAGE(PG8_SA(0, 0), a2, voffA);
            PG8_WAIT_V(8); PG8_WAIT_L(0); PG8_BAR; PG8_MMA(1, 0, At, B0); PG8_MMA(1, 1, At, B1); PG8_BAR; PG8_SCHED;
            PG8_LDB(B0, 1, 0); PG8_LDB(B1, 1, 1); PG8_SCHED; PG8_LDA(At, 1, 0); PG8_STAGE(PG8_SA(0, 1), a2 + hstep, voffA);
            PG8_WAIT_V(8); PG8_WAIT_L(0); PG8_BAR; PG8_MMA(0, 0, At, B0); PG8_MMA(0, 1, At, B1); PG8_BAR; PG8_SCHED;
            PG8_LDA(At, 1, 1); PG8_STAGE(PG8_SB(1, 0), b3, voffB); PG8_STAGE(PG8_SB(1, 1), b3 + hstep, voffB); PG8_STAGE(PG8_SA(1, 0), a3, voffA);
            PG8_WAIT_V(8); PG8_WAIT_L(0); PG8_BAR; PG8_MMA(1, 0, At, B0); PG8_MMA(1, 1, At, B1); PG8_BAR; PG8_SCHED;
            } else {
            PG8_LDB(B0, 0, 0); PG8_SCHED; PG8_LDA(At, 0, 0); PG8_STAGE(PG8_SA(1, 1), a1 + hstep, voffA);
            PG8_WAIT_L(8); PG8_BAR; PG8_WAIT_L(0); PG8_MMA(0, 0, At, B0); PG8_BAR; PG8_SCHED;
            PG8_LDB(B1, 0, 1); PG8_STAGE(PG8_SB(0, 0), b2, voffB);
            PG8_BAR; PG8_WAIT_L(0); PG8_MMA(0, 1, At, B1); PG8_BAR;
            PG8_LDA(At, 0, 1); PG8_STAGE(PG8_SA(0, 0), a2, voffA);
            PG8_BAR; PG8_WAIT_L(0); PG8_MMA(1, 0, At, B0); PG8_BAR; PG8_SCHED;
            PG8_STAGE(PG8_SB(0, 1), b2 + hstep, voffB);
            PG8_WAIT_V(6); PG8_BAR; PG8_MMA(1, 1, At, B1); PG8_BAR;
            PG8_LDB(B0, 1, 0); PG8_SCHED; PG8_LDA(At, 1, 0); PG8_STAGE(PG8_SA(0, 1), a2 + hstep, voffA);
            PG8_WAIT_L(8); PG8_BAR; PG8_WAIT_L(0); PG8_MMA(0, 0, At, B0); PG8_BAR; PG8_SCHED;
            PG8_LDB(B1, 1, 1); PG8_STAGE(PG8_SB(1, 0), b3, voffB);
            PG8_BAR; PG8_WAIT_L(0); PG8_MMA(0, 1, At, B1); PG8_BAR;
            PG8_LDA(At, 1, 1); PG8_STAGE(PG8_SA(1, 0), a3, voffA);
            PG8_BAR; PG8_WAIT_L(0); PG8_MMA(1, 0, At, B0); PG8_BAR; PG8_SCHED;
            PG8_STAGE(PG8_SB(1, 1), b3 + hstep, voffB);
            PG8_WAIT_V(6); PG8_BAR; PG8_MMA(1, 1, At, B1); PG8_BAR;
            }
        }
        if constexpr (ALIGN_EPI) { if (wr == 0) PG8_BAR; }
        if constexpr (!Epi::AFTER_DRAIN) { E(acc, cur, wr, wc, fr, fq); S.done(cur); }
        if (!has_next) break;
#pragma unroll
        for (int a = 0; a < 2; ++a)
#pragma unroll
            for (int b = 0; b < 2; ++b)
#pragma unroll
                for (int m = 0; m < 4; ++m)
#pragma unroll
                    for (int n = 0; n < 2; ++n) acc[a][b][m][n] = (f32x4){0.f, 0.f, 0.f, 0.f};
        cur = nxt; cA = nA; cB = nB; ++ui;
        if constexpr (ALIGN_EPI) { if (wr == 1) PG8_BAR; }
    }
    PG8_WAIT_V(0);
    if constexpr (!ALIGN_EPI) { if (wr == 0) PG8_BAR; }
    PG8_BAR;
    if constexpr (Epi::AFTER_DRAIN) { E.fused(acc, cur, wr, wc, fr, fq, lds, wid, lane); S.done(cur); }
#undef PG8_SA
#undef PG8_SB
#undef PG8_STAGE
#undef PG8_LDA
#undef PG8_LDB
#undef PG8_MMA
#undef PG8_WAIT_V
#undef PG8_WAIT_L
#undef PG8_BAR
#undef PG8_SCHED
}
}

#define LAS __attribute__((address_space(3)))
using pg8::bf16_t; using pg8::bf16x8; using pg8::f32x4; using pg8::u32x4;
typedef unsigned u32x2 __attribute__((ext_vector_type(2)));
typedef unsigned long long u64;

constexpr int NT = 512;
constexpr int M = 32768, D = 1024, T = 8192, NB = 4;
constexpr int DFF = 2816, DFF2 = 5632;
constexpr int EVEN_COLS = 3652, EVEN_PAD = 3840, PR_LD = 1792, PD_LD = 2048, ODD_COLS = 1536;
constexpr float ALPHA = 1.681792830507429f;
constexpr float LN_EPS = 1e-5f, GN_EPS = 64e-5f;
constexpr int LDS_BYTES = 147456, TAB_OFF = 140288;
constexpr size_t MiB = 1u << 20;
constexpr size_t WS_MOD = 1 * MiB;
constexpr size_t WS_WIN = 2 * MiB, WS_WOUT = 10 * MiB, WS_WUP = 12 * MiB, WS_WDN = 24 * MiB;
constexpr size_t WS_SMALL = 30 * MiB;
constexpr size_t WS_H = 32 * MiB;
constexpr size_t WS_YC = 96 * MiB;
constexpr size_t WS_PR = 160 * MiB;
constexpr size_t WS_PD = 272 * MiB;
constexpr size_t WS_MASK = 400 * MiB;
constexpr size_t WS_SCRA = 96 * MiB, WS_SCRB = 432 * MiB;
constexpr size_t WS_E = 272 * MiB, WS_A = 304 * MiB, WS_G = 336 * MiB, WS_SINIT = 368 * MiB, WS_QP = 400 * MiB, WS_OU = 432 * MiB, WS_PU = 32 * MiB;
constexpr size_t WS_HID = 160 * MiB, WS_SIDE = 336 * MiB;
constexpr size_t WS_KC = 32 * MiB, WS_VC = 64 * MiB, WS_KI = 496 * MiB, WS_ROPE = 500 * MiB;
constexpr size_t WS_NEED = 512 * MiB;

__device__ __forceinline__ int otid_(int wv) { int l; asm volatile("v_mbcnt_lo_u32_b32 %0, -1, 0\n\tv_mbcnt_hi_u32_b32 %0, -1, %0" : "=v"(l)); return wv * 64 + l; }
__device__ __forceinline__ unsigned ozero() { unsigned z; asm volatile("v_mov_b32 %0, 0" : "=v"(z)); return z; }
__device__ __forceinline__ float bf2f(unsigned v) { return __builtin_bit_cast(float, v << 16); }
__device__ __forceinline__ unsigned f2bf(float f) { unsigned u = __builtin_bit_cast(unsigned, f); return (u + 0x7fffu + ((u >> 16) & 1u)) >> 16; }
__device__ __forceinline__ unsigned pk2(float lo, float hi) { return f2bf(lo) | (f2bf(hi) << 16); }
#ifndef USE_DPP_SUM
#define USE_DPP_SUM 1
#endif
__device__ __forceinline__ float dpp_row_shr(float v, int n) {
    const int iv = __builtin_bit_cast(int, v); int r;
    switch (n) { case 1: r = __builtin_amdgcn_update_dpp(0, iv, 0x111, 0xf, 0xf, true); break; case 2: r = __builtin_amdgcn_update_dpp(0, iv, 0x112, 0xf, 0xf, true); break;
                 case 4: r = __builtin_amdgcn_update_dpp(0, iv, 0x114, 0xf, 0xf, true); break; default: r = __builtin_amdgcn_update_dpp(0, iv, 0x118, 0xf, 0xf, true); break; }
    return __builtin_bit_cast(float, r);
}
__device__ __forceinline__ float wave_sum(float v) {
#if USE_DPP_SUM
    v += dpp_row_shr(v, 1); v += dpp_row_shr(v, 2); v += dpp_row_shr(v, 4); v += dpp_row_shr(v, 8);
    v += __builtin_bit_cast(float, __builtin_amdgcn_update_dpp(0, __builtin_bit_cast(int, v), 0x142, 0xa, 0xf, false));
    v += __builtin_bit_cast(float, __builtin_amdgcn_update_dpp(0, __builtin_bit_cast(int, v), 0x143, 0xc, 0xf, false));
    return __builtin_bit_cast(float, __builtin_amdgcn_readlane(__builtin_bit_cast(int, v), 63));
#else
#pragma unroll
    for (int o = 1; o < 64; o <<= 1) v += __shfl_xor(v, o);
    return v;
#endif
}
__device__ __forceinline__ f32x4 ld4(const float* p) { return *(const f32x4*)p; }
__device__ __forceinline__ float gelu_exact(float x) { return 0.5f * x * (1.f + erff(x * 0.70710678118654752f)); }
__device__ __forceinline__ float sigmoidf_(float x) { return 1.f / (1.f + expf(-x)); }
__device__ __forceinline__ void unpack8(u32x4 w, float* f) {
    f[0] = bf2f(w.x & 0xffffu); f[1] = bf2f(w.x >> 16); f[2] = bf2f(w.y & 0xffffu); f[3] = bf2f(w.y >> 16);
    f[4] = bf2f(w.z & 0xffffu); f[5] = bf2f(w.z >> 16); f[6] = bf2f(w.w & 0xffffu); f[7] = bf2f(w.w >> 16);
}
__device__ __forceinline__ bf16x8 pack8(const float* f) {
    u32x4 w; w.x = pk2(f[0], f[1]); w.y = pk2(f[2], f[3]); w.z = pk2(f[4], f[5]); w.w = pk2(f[6], f[7]);
    return __builtin_bit_cast(bf16x8, w);
}
#define MFMA16(a, b, c) __builtin_amdgcn_mfma_f32_16x16x32_bf16((a), (b), (c), 0, 0, 0)

namespace pg8 {
struct EpiStoreP {
    static constexpr bool PERM = true, AFTER_DRAIN = false;
    bf16_t* P0; int ld0; int ntile0; bf16_t* P1; int ld1;
    __device__ __forceinline__ void operator()(const f32x4 (&acc)[2][2][4][2], const Unit& u, int wr, int wc, int fr, int fq) const {
        bf16_t* base; int ld, colt;
        if (u.pn < ntile0) { base = P0; ld = ld0; colt = u.pn * 256; } else { base = P1; ld = ld1; colt = (u.pn - ntile0) * 256; }
        const int row0 = u.pm * BM + wr * 64 + fr, col0 = colt + wc * 32 + 8 * fq;
#pragma unroll
        for (int ai = 0; ai < 2; ++ai)
#pragma unroll
            for (int m = 0; m < 4; ++m) { bf16_t* rowp = base + (size_t)(row0 + ai * HALF + m * 16) * ld + col0;
#pragma unroll
                for (int bj = 0; bj < 2; ++bj) { const f32x4 v0 = acc[ai][bj][m][0], v1 = acc[ai][bj][m][1];
                    u32x4 w; w.x = cvt_pk_bf16(v0[0], v0[1]); w.y = cvt_pk_bf16(v0[2], v0[3]); w.z = cvt_pk_bf16(v1[0], v1[1]); w.w = cvt_pk_bf16(v1[2], v1[3]);
                    *(u32x4*)(rowp + bj * HALF) = w; } }
    }
};
struct EpiResid {
    static constexpr bool PERM = true, AFTER_DRAIN = false;
    const float* xsrc; float* X; const float* gate;
    __device__ __forceinline__ void operator()(const f32x4 (&acc)[2][2][4][2], const Unit& u, int wr, int wc, int fr, int fq) const {
        const int row0 = u.pm * BM + wr * 64 + fr, col0 = u.pn * BM + wc * 32 + 8 * fq;
#pragma unroll
        for (int ai = 0; ai < 2; ++ai)
#pragma unroll
            for (int m = 0; m < 4; ++m) { const int row = row0 + ai * HALF + m * 16; const float* gp = gate + (row >> 13) * 6144;
#pragma unroll
                for (int bj = 0; bj < 2; ++bj)
#pragma unroll
                    for (int n = 0; n < 2; ++n) { const int c = col0 + bj * HALF + 4 * n; const size_t o = (size_t)row * 1024 + c;
                        const f32x4 g = *(const f32x4*)(gp + c), xs = *(const f32x4*)(xsrc + o);
                        *(f32x4*)(X + o) = xs * 1.681792830507429f + g * acc[ai][bj][m][n]; } }
    }
};
struct EpiFFN {
    static constexpr bool PERM = true, AFTER_DRAIN = false;
    bf16_t* HID; float* side; const float* cw; const float* cb;
    __device__ __forceinline__ void operator()(const f32x4 (&acc)[2][2][4][2], const Unit& u, int wr, int wc, int fr, int fq) const {
        const int lane = fq * 16 + fr;
        const int src1 = (lane & 48) | ((fr + 15) & 15), src2 = (lane & 48) | ((fr + 14) & 15);
#pragma unroll
        for (int n = 0; n < 2; ++n) {
            const int hc = u.pn * 128 + wc * 32 + 8 * fq + 4 * n;
#pragma unroll
            for (int ai = 0; ai < 2; ++ai) {
                const int blk = u.pm * 4 + ai * 2 + wr;
                f32x4 pg1 = {0.f, 0.f, 0.f, 0.f}, pg2 = pg1, pv1 = pg1, pv2 = pg1;
#pragma unroll
                for (int m = 0; m < 4; ++m) {
                    const f32x4 cgv = acc[ai][0][m][n], cvv = acc[ai][1][m][n];
                    f32x4 rg1, rg2, rv1, rv2;
#pragma unroll
                    for (int j = 0; j < 4; ++j) { rg1[j] = __shfl(cgv[j], src1); rg2[j] = __shfl(cgv[j], src2); rv1[j] = __shfl(cvv[j], src1); rv2[j] = __shfl(cvv[j], src2); }
                    f32x4 ug1, ug2, uv1, uv2;
#pragma unroll
                    for (int j = 0; j < 4; ++j) { ug1[j] = fr >= 1 ? rg1[j] : pg1[j]; ug2[j] = fr >= 2 ? rg2[j] : pg2[j]; uv1[j] = fr >= 1 ? rv1[j] : pv1[j]; uv2[j] = fr >= 2 ? rv2[j] : pv2[j]; }
                    pg1 = rg1; pg2 = rg2; pv1 = rv1; pv2 = rv2;
                    const float* cwp = cw + hc; asm volatile("" : "+v"(cwp));
                    f32x4 gate = *(const f32x4*)(cb + hc) + *(const f32x4*)(cwp) * ug2 + *(const f32x4*)(cwp + 5632) * ug1 + *(const f32x4*)(cwp + 11264) * cgv;
                    float h[4];
#pragma unroll
                    for (int j = 0; j < 4; ++j) h[j] = gate[j] / (1.f + __expf(-gate[j]));
                    const f32x4 val = *(const f32x4*)(cb + 2816 + hc) + *(const f32x4*)(cwp + 2816) * uv2 + *(const f32x4*)(cwp + 5632 + 2816) * uv1 + *(const f32x4*)(cwp + 11264 + 2816) * cvv;
#pragma unroll
                    for (int j = 0; j < 4; ++j) h[j] *= val[j];
                    const int row = u.pm * BM + ai * HALF + wr * 64 + m * 16 + fr;
                    if (!(m == 0 && fr < 2)) { u32x2 w; w.x = cvt_pk_bf16(h[0], h[1]); w.y = cvt_pk_bf16(h[2], h[3]); *(u32x2*)(HID + (size_t)row * 2816 + hc) = w; }
                    if (m == 0 && fr < 2) { float* sp = side + (size_t)(blk * 4 + fr) * 5632 + hc; *(f32x4*)sp = cgv; *(f32x4*)(sp + 2816) = cvv; }
                    if (m == 3 && fr >= 14) { float* sp = side + (size_t)(blk * 4 + 2 + (fr - 14)) * 5632 + hc; *(f32x4*)sp = cgv; *(f32x4*)(sp + 2816) = cvv; }
                }
            }
        }
    }
};
}

__device__ __forceinline__ void phase_mod(LAS unsigned char* lds, const float* c, const float* ada_w, const float* ada_b, float* MOD, int tid) {
    LAS float* cact = (LAS float*)lds;
    LAS float* red = cact + 4096;
    for (int i = tid; i < 4096; i += NT) { const float v = c[i]; cact[i] = v / (1.f + expf(-v)); }
    __syncthreads();
    const int nl = tid & 63, kg = tid >> 6;
    for (int u = blockIdx.x; u < 384; u += gridDim.x) {
        const int l = u / 96, n0 = (u % 96) * 64;
        const float* w = ada_w + ((size_t)l * 1024 + kg * 128) * 6144 + n0 + nl;
        float a0 = 0.f, a1 = 0.f, a2 = 0.f, a3 = 0.f;
#pragma unroll 8
        for (int k = 0; k < 128; ++k) { const float wv = w[(size_t)k * 6144]; const int kk = kg * 128 + k;
            a0 += cact[kk] * wv; a1 += cact[1024 + kk] * wv; a2 += cact[2048 + kk] * wv; a3 += cact[3072 + kk] * wv; }
        LAS float* r = red + (kg * 64 + nl) * 4; r[0] = a0; r[1] = a1; r[2] = a2; r[3] = a3;
        __syncthreads();
        if (tid < 256) { const int b = tid >> 6; float s = ada_b[l * 6144 + n0 + nl];
#pragma unroll
            for (int g = 0; g < 8; ++g) s += red[(g * 64 + nl) * 4 + b];
            MOD[(size_t)(l * 4 + b) * 6144 + n0 + nl] = s; }
        __syncthreads();
    }
}

template <int MODE>
__device__ __forceinline__ void cvt_item(const float* W, int K, int N, int Npad, bf16_t* WT, LAS float* scr, int item, int lane) {
    const int nblk = Npad / 32, kb = item / nblk, nb = item % nblk, k0 = 64 * kb, n0 = 32 * nb;
#pragma unroll 8
    for (int i = 0; i < 32; ++i) { const int kk = 2 * i + (lane >> 5), n = n0 + (lane & 31); scr[kk * 33 + (lane & 31)] = (n < N) ? W[(size_t)(k0 + kk) * N + n] : 0.f; }
    asm volatile("s_waitcnt lgkmcnt(0)" ::: "memory");
    const int c = lane & 7;
#pragma unroll
    for (int j = 0; j < 4; ++j) { const int nl = (lane >> 3) + 8 * j; const LAS float* s = scr + (8 * c) * 33 + nl;
        u32x4 o; o.x = pk2(s[0 * 33], s[1 * 33]); o.y = pk2(s[2 * 33], s[3 * 33]); o.z = pk2(s[4 * 33], s[5 * 33]); o.w = pk2(s[6 * 33], s[7 * 33]);
        int n = n0 + nl, row = n;
        if (MODE == 1) row = (n < 2816) ? ((n >> 7) * 256 + (n & 127)) : (((n - 2816) >> 7) * 256 + 128 + ((n - 2816) & 127));
        *(u32x4*)(WT + (size_t)row * K + k0 + 8 * c) = o; }
    asm volatile("s_waitcnt lgkmcnt(0)" ::: "memory");
}

struct CvtPtrs { const float *w_in, *w_out, *w_up, *w_dn, *s0, *s1, *s2; };
__device__ __forceinline__ void phase_convert(LAS unsigned char* lds, unsigned char* ws, const CvtPtrs cp, bool even, int tid) {
    const int wave = __builtin_amdgcn_readfirstlane(tid >> 6), lane = tid & 63;
    LAS float* scr = (LAS float*)lds + wave * (64 * 33 + 16);
    const int gw = blockIdx.x * 8 + wave, NGW = gridDim.x * 8;
    bf16_t* WIN = (bf16_t*)(ws + WS_WIN); bf16_t* WOUT = (bf16_t*)(ws + WS_WOUT); bf16_t* WUP = (bf16_t*)(ws + WS_WUP); bf16_t* WDN = (bf16_t*)(ws + WS_WDN);
    bf16_t* SM = (bf16_t*)(ws + WS_SMALL);
    const int n_in = even ? EVEN_COLS : ODD_COLS, npad_in = even ? EVEN_PAD : ODD_COLS;
    const int I_IN = 16 * (npad_in / 32), I_OUT = 16 * 32, I_UP = 16 * 176, I_DN = 44 * 32;
    const int I_S = even ? (16 + 16 + 32) : (4 * 8);
    const int total = I_IN + I_OUT + I_UP + I_DN + I_S;
    for (int it = gw; it < total; it += NGW) {
        int r = it;
        if (r < I_IN) { cvt_item<0>(cp.w_in, 1024, n_in, npad_in, WIN, scr, r, lane); continue; } r -= I_IN;
        if (r < I_OUT) { cvt_item<0>(cp.w_out, 1024, 1024, 1024, WOUT, scr, r, lane); continue; } r -= I_OUT;
        if (r < I_UP) { cvt_item<1>(cp.w_up, 1024, 5632, 5632, WUP, scr, r, lane); continue; } r -= I_UP;
        if (r < I_DN) { cvt_item<0>(cp.w_dn, 2816, 1024, 1024, WDN, scr, r, lane); continue; } r -= I_DN;
        if (even) {
            if (r < 16) { cvt_item<0>(cp.s0, 64, 512, 512, SM, scr, r, lane); continue; } r -= 16;
            if (r < 16) { cvt_item<0>(cp.s1, 64, 512, 512, SM + 32768, scr, r, lane); continue; } r -= 16;
            cvt_item<0>(cp.s2, 128, 512, 512, SM + 65536, scr, r, lane);
        } else {
            const int g = r >> 3; cvt_item<0>(cp.s0 + g * 16384, 128, 128, 128, SM + 131072 + g * 16384, scr, r & 7, lane);
        }
    }
    if (!even) {
        bf16_t* SGW = SM + 196608;
        for (int i = blockIdx.x * NT + tid; i < 65536; i += gridDim.x * NT) { const int s = i & 127, t = (i >> 7) & 127; SGW[i] = (bf16_t)f2bf(s <= t ? cp.s1[i] : 0.f); }
    }
}

__device__ __forceinline__ void phase_h0(const float* x, const float* MOD, bf16_t* H, int tid) {
    const int wave = __builtin_amdgcn_readfirstlane(tid >> 6), lane = tid & 63;
    for (int row = blockIdx.x * 8 + wave; row < M; row += gridDim.x * 8) {
        const float* mp = MOD + (size_t)(row >> 13) * 6144;
#pragma unroll
        for (int j = 0; j < 4; ++j) { const int c = 4 * (lane + 64 * j);
            const f32x4 v = ld4(x + (size_t)row * 1024 + c), sh = ld4(mp + c), sc = ld4(mp + 1024 + c);
            u32x2 w; w.x = pk2(v[0] * (1.f + sc[0]) + sh[0], v[1] * (1.f + sc[1]) + sh[1]); w.y = pk2(v[2] * (1.f + sc[2]) + sh[2], v[3] * (1.f + sc[3]) + sh[3]);
            *(u32x2*)(H + (size_t)row * 1024 + c) = w; }
    }
}

__device__ __forceinline__ void phase_ln(float* X, const float* lg, const float* lb, const float* modp  , bf16_t* H, int tid) {
    const int wave = __builtin_amdgcn_readfirstlane(tid >> 6), lane = tid & 63;
    const int stride = gridDim.x * 8;
    for (int row0 = blockIdx.x * 8 + wave; row0 < M; row0 += 4 * stride) {
        int rows[4];
#pragma unroll
        for (int u = 0; u < 4; ++u) rows[u] = (row0 + u * stride < M) ? row0 + u * stride : row0;
        f32x4 v[4][4];
#pragma unroll
        for (int u = 0; u < 4; ++u)
#pragma unroll
            for (int j = 0; j < 4; ++j) v[u][j] = ld4(X + (size_t)rows[u] * 1024 + 4 * (lane + 64 * j));
#pragma unroll
        for (int u = 0; u < 4; ++u) {
            if (u > 0 && rows[u] == rows[0]) break;
            const int row = rows[u];
            float s = 0.f;
#pragma unroll
            for (int j = 0; j < 4; ++j) s += (v[u][j][0] + v[u][j][1]) + (v[u][j][2] + v[u][j][3]);
            const float mean = wave_sum(s) * (1.f / 1024.f); float s2 = 0.f;
#pragma unroll
            for (int j = 0; j < 4; ++j) { v[u][j] = v[u][j] - mean; s2 += (v[u][j][0] * v[u][j][0] + v[u][j][1] * v[u][j][1]) + (v[u][j][2] * v[u][j][2] + v[u][j][3] * v[u][j][3]); }
            const float rstd = 1.f / sqrtf(wave_sum(s2) * (1.f / 1024.f) + LN_EPS);
#pragma unroll
            for (int j = 0; j < 4; ++j) { const int c = 4 * (lane + 64 * j);
                const f32x4 y = v[u][j] * rstd * ld4(lg + c) + ld4(lb + c);
                *(f32x4*)(X + (size_t)row * 1024 + c) = y;
                if (modp) { const float* mp = modp + (size_t)(row >> 13) * 6144; const f32x4 sh = ld4(mp + c), sc = ld4(mp + 1024 + c);
                    u32x2 w; w.x = pk2(y[0] * (1.f + sc[0]) + sh[0], y[1] * (1.f + sc[1]) + sh[1]); w.y = pk2(y[2] * (1.f + sc[2]) + sh[2], y[3] * (1.f + sc[3]) + sh[3]);
                    *(u32x2*)(H + (size_t)row * 1024 + c) = w; }
            }
        }
    }
}

__device__ __forceinline__ void phase_ffn_fix(const float* side, const float* cw, const float* cb, bf16_t* HID, int tid) {
    for (int idx = blockIdx.x * NT + tid; idx < 512 * 2 * 2816; idx += gridDim.x * NT) {
        const int col = idx % 2816, q = (idx / 2816) & 1, blk = idx / 5632;
        const bool first = ((blk * 64) & 8191) == 0;
        const float* s0 = side + (size_t)(blk * 4) * 5632;
        const float* sp = side + (size_t)(blk * 4 - 4) * 5632;
        float g0 = s0[q * 5632 + col], v0 = s0[q * 5632 + 2816 + col], g1, v1, g2, v2;
        if (q == 1) { g1 = s0[col]; v1 = s0[2816 + col]; g2 = first ? 0.f : sp[3 * 5632 + col]; v2 = first ? 0.f : sp[3 * 5632 + 2816 + col]; }
        else { g1 = first ? 0.f : sp[3 * 5632 + col]; v1 = first ? 0.f : sp[3 * 5632 + 2816 + col]; g2 = first ? 0.f : sp[2 * 5632 + col]; v2 = first ? 0.f : sp[2 * 5632 + 2816 + col]; }
        const float gate = cb[col] + cw[col] * g2 + cw[5632 + col] * g1 + cw[11264 + col] * g0;
        const float val = cb[2816 + col] + cw[2816 + col] * v2 + cw[5632 + 2816 + col] * v1 + cw[11264 + 2816 + col] * v0;
        HID[(size_t)(blk * 64 + q) * 2816 + col] = (bf16_t)f2bf(gate / (1.f + expf(-gate)) * val);
    }
}

__device__ __forceinline__ void phase_pool(const bf16_t* P, const bf16_t* POOLT, const float* pscale, bf16_t* YC, int tid) {
    const int wave = __builtin_amdgcn_readfirstlane(tid >> 6), lane = tid & 63, l15 = lane & 15, quad = lane >> 4;
    for (int uid = blockIdx.x * 8 + wave; uid < 8192; uid += gridDim.x * 8) {
        const int g = uid & 3, row0 = (uid >> 2) * 16, row = row0 + l15, t = row & 8191, w = 2 << g;
        const float inv = 1.f / (float)((t + 1 < w) ? (t + 1) : w);
        bf16x8 afr[4];
#pragma unroll
        for (int ks = 0; ks < 4; ++ks) {
            const int c0 = g * 128 + ks * 32 + quad * 8;
            float sum[8], x0[8];
            unpack8(*(const u32x4*)(P + (size_t)row * 1536 + c0), x0);
#pragma unroll
            for (int j = 0; j < 8; ++j) sum[j] = x0[j];
#pragma unroll 4
            for (int d = 1; d < w; ++d) if (t - d >= 0) { float xv[8]; unpack8(*(const u32x4*)(P + (size_t)(row - d) * 1536 + c0), xv);
#pragma unroll
                for (int j = 0; j < 8; ++j) sum[j] += xv[j]; }
#pragma unroll
            for (int j = 0; j < 8; ++j) sum[j] = sum[j] * inv - x0[j];
            afr[ks] = pack8(sum);
        }
#pragma unroll
        for (int nt = 0; nt < 8; ++nt) {
            f32x4 acc = {0.f, 0.f, 0.f, 0.f};
#pragma unroll
            for (int ks = 0; ks < 4; ++ks) { const bf16x8 wb = *(const bf16x8*)(POOLT + g * 16384 + (16 * nt + l15) * 128 + ks * 32 + quad * 8); acc = MFMA16(wb, afr[ks], acc); }
            const int d0 = g * 128 + 16 * nt + 4 * quad; const f32x4 sc = ld4(pscale + d0);
            u32x2 o; o.x = pk2(acc[0] * sc[0], acc[1] * sc[1]); o.y = pk2(acc[2] * sc[2], acc[3] * sc[3]);
            *(u32x2*)(YC + (size_t)row * 1024 + d0) = o;
        }
    }
}

__device__ __forceinline__ void phase_sgu(LAS unsigned char* lds, const bf16_t* P, const bf16_t* SGW, const float* lng, const float* lnb, const float* sgb, bf16_t* YC, int tid) {
    const int wave = __builtin_amdgcn_readfirstlane(tid >> 6), lane = tid & 63, l15 = lane & 15, quad = lane >> 4;
    LAS bf16_t* Vt = (LAS bf16_t*)lds;
    for (int u = blockIdx.x; u < 256; u += gridDim.x) {
        const int row0 = u * 128;
        {
            const int c0 = lane * 8; float gam[8], bet[8];
#pragma unroll
            for (int j = 0; j < 8; ++j) { gam[j] = lng[c0 + j]; bet[j] = lnb[c0 + j]; }
            for (int si = 0; si < 16; ++si) {
                const int s = wave * 16 + si; float v[8];
                unpack8(*(const u32x4*)(P + (size_t)(row0 + s) * 1536 + 1024 + c0), v);
                float sm = 0.f;
#pragma unroll
                for (int j = 0; j < 8; ++j) { v[j] = gelu_exact(v[j]); sm += v[j]; }
                const float mean = wave_sum(sm) * (1.f / 512.f); float s2 = 0.f;
#pragma unroll
                for (int j = 0; j < 8; ++j) { v[j] -= mean; s2 += v[j] * v[j]; }
                const float rstd = 1.f / sqrtf(wave_sum(s2) * (1.f / 512.f) + LN_EPS);
#pragma unroll
                for (int j = 0; j < 8; ++j) Vt[(c0 + j) * 136 + s] = (bf16_t)f2bf(v[j] * rstd * gam[j] + bet[j]);
            }
        }
        __syncthreads();
        {
            const int t = wave * 16 + l15, nks = (wave * 16 + 15) / 32 + 1;
            for (int g = 0; g < 4; ++g) {
                bf16x8 wf[4];
#pragma unroll
                for (int ks = 0; ks < 4; ++ks) if (ks < nks) wf[ks] = *(const bf16x8*)(SGW + g * 16384 + t * 128 + ks * 32 + quad * 8); else wf[ks] = (bf16x8){0, 0, 0, 0, 0, 0, 0, 0};
                const float bs = sgb[g * 128 + t];
#pragma unroll
                for (int nt = 0; nt < 8; ++nt) {
                    f32x4 acc = {0.f, 0.f, 0.f, 0.f};
#pragma unroll
                    for (int ks = 0; ks < 4; ++ks) if (ks < nks) { const bf16x8 vf = *(const LAS bf16x8*)(Vt + (g * 128 + 16 * nt + l15) * 136 + ks * 32 + quad * 8); acc = MFMA16(vf, wf[ks], acc); }
                    const int c = g * 128 + 16 * nt + 4 * quad;
                    const u32x2 uw = *(const u32x2*)(P + (size_t)(row0 + t) * 1536 + 512 + c);
                    const float u0 = gelu_exact(bf2f(uw.x & 0xffffu)), u1 = gelu_exact(bf2f(uw.x >> 16)), u2 = gelu_exact(bf2f(uw.y & 0xffffu)), u3 = gelu_exact(bf2f(uw.y >> 16));
                    u32x2 o; o.x = pk2(u0 * (acc[0] + bs), u1 * (acc[1] + bs)); o.y = pk2(u2 * (acc[2] + bs), u3 * (acc[3] + bs));
                    *(u32x2*)(YC + (size_t)(row0 + t) * 1024 + 512 + c) = o;
                }
            }
        }
        __syncthreads();
    }
}

__device__ __forceinline__ void phase_rope_table(float* ROPE, int tid) {
    for (int i = blockIdx.x * NT + tid; i < 8192 * 8; i += gridDim.x * NT) { const int t = i >> 3, f = i & 7;
        const float ang = (float)t * powf(500000.0f, -(float)(2 * f) / 16.0f); ROPE[t * 16 + f] = cosf(ang); ROPE[t * 16 + 8 + f] = sinf(ang); }
}
__device__ __forceinline__ void phase_dsa_prep(bf16_t* PD, const float* ikg, const float* ikb, const float* ROPE, bf16_t* Kc, bf16_t* Vc, bf16_t* KI, int tid) {
    const int wave = __builtin_amdgcn_readfirstlane(tid >> 6), lane = tid & 63, f = lane & 7;
    const float g = ikg[lane], bb = ikb[lane];
    for (int row = blockIdx.x * 8 + wave; row < M; row += gridDim.x * 8) {
        bf16_t* pd = PD + (size_t)row * PD_LD;
        const int t = row & 8191, b = row >> 13;
        const float* rt = ROPE + t * 16;
        const float cs = rt[f], sn = rt[8 + f];
#pragma unroll
        for (int i = 0; i < 2; ++i) { const int p = lane + 64 * i;
            if (p < 96) { const int head = p >> 3; const int base = head < 8 ? head * 64 : 1536 + (head - 8) * 64;
                const float x1 = bf2f(pd[base + f]), x2 = bf2f(pd[base + 8 + f]);
                pd[base + f] = (bf16_t)f2bf(x1 * cs - x2 * sn); pd[base + 8 + f] = (bf16_t)f2bf(x1 * sn + x2 * cs); } }
        {
            const int head = lane >> 3, seg = lane & 7;
            u32x4 kw = *(const u32x4*)(pd + 512 + head * 64 + seg * 8);
            const u32x4 vw = *(const u32x4*)(pd + 1024 + head * 64 + seg * 8);
            u32x4 kx; kx.x = __shfl_xor(kw.x, 1); kx.y = __shfl_xor(kw.y, 1); kx.z = __shfl_xor(kw.z, 1); kx.w = __shfl_xor(kw.w, 1);
            if (seg < 2) {
                float a[8], o8[8], c8[8], s8[8]; unpack8(kw, a); unpack8(kx, o8);
                const f32x4 c0 = ld4(rt), c1 = ld4(rt + 4), s0 = ld4(rt + 8), s1 = ld4(rt + 12);
                c8[0] = c0[0]; c8[1] = c0[1]; c8[2] = c0[2]; c8[3] = c0[3]; c8[4] = c1[0]; c8[5] = c1[1]; c8[6] = c1[2]; c8[7] = c1[3];
                s8[0] = s0[0]; s8[1] = s0[1]; s8[2] = s0[2]; s8[3] = s0[3]; s8[4] = s1[0]; s8[5] = s1[1]; s8[6] = s1[2]; s8[7] = s1[3];
#pragma unroll
                for (int j = 0; j < 8; ++j) a[j] = (seg == 0) ? (a[j] * c8[j] - o8[j] * s8[j]) : (o8[j] * s8[j] + a[j] * c8[j]);
                kw = __builtin_bit_cast(u32x4, pack8(a));
            }
            const size_t co = ((size_t)((b * 8 + head) * 8192 + t)) * 64 + seg * 8;
            *(u32x4*)(Kc + co) = kw; *(u32x4*)(Vc + co) = vw;
        }
        const float v = bf2f(pd[1792 + lane]);
        const float mean = wave_sum(v) * (1.f / 64.f), d = v - mean, var = wave_sum(d * d) * (1.f / 64.f);
        const float y = d * (1.f / sqrtf(var + LN_EPS)) * g + bb;
        const float yp = __shfl(y, lane < 8 ? lane + 8 : (lane < 16 ? lane - 8 : lane));
        float o = y;
        if (lane < 8) o = y * cs - yp * sn; else if (lane < 16) o = yp * sn + y * cs;
        KI[(size_t)row * 64 + lane] = (bf16_t)f2bf(o);
        if (lane < 4) pd[1856 + lane] = (bf16_t)f2bf(bf2f(pd[1856 + lane]) * 0.0625f);
    }
}

__device__ __forceinline__ unsigned fkey(float s) { const unsigned u = __builtin_bit_cast(unsigned, s); return (u & 0x80000000u) ? ~u : (u | 0x80000000u); }

__device__ __forceinline__ void phase_dsa_select(LAS unsigned char* lds, const bf16_t* PD, const bf16_t* KI, float* scr, u64* MASK, int tid) {
    const int wave = __builtin_amdgcn_readfirstlane(tid >> 6), lane = tid & 63, l15 = lane & 15, quad = lane >> 4;
    LAS unsigned* hist = (LAS unsigned*)lds + wave * 1024;
    const int G = gridDim.x, bid = blockIdx.x;
    for (int it = 0;; ++it) {
        const int uo = it * G + ((it & 1) ? (G - 1 - bid) : bid);
        if (uo >= 2048) break;
        const int tq = 511 - (uo >> 2), b = uo & 3, t0 = tq * 16, c = t0 >> 6, nkeys = (c + 1) * 64, row0 = b * 8192 + t0;
        if (c <= 3) {
            for (int idx = tid; idx < 16 * (c + 1); idx += NT) { const int q = idx / (c + 1), j = idx % (c + 1); const unsigned on = ~ozero(); MASK[(size_t)(row0 + q) * 128 + j] = ((u64)on << 32) | on; }
            continue;
        }
        {
            bf16x8 qa[4][2]; float wq[4][4];
#pragma unroll
            for (int h = 0; h < 4; ++h)
#pragma unroll
                for (int ks = 0; ks < 2; ++ks) qa[h][ks] = *(const bf16x8*)(PD + (size_t)(row0 + l15) * PD_LD + 1536 + h * 64 + ks * 32 + quad * 8);
#pragma unroll
            for (int r = 0; r < 4; ++r)
#pragma unroll
                for (int h = 0; h < 4; ++h) wq[r][h] = bf2f(PD[(size_t)(row0 + quad * 4 + r) * PD_LD + 1856 + h]);
            const bf16_t* kbase = KI + (size_t)(b * 8192 + l15) * 64 + quad * 8;
            const int ntile = nkeys / 16;
            for (int t0 = wave; t0 < ntile; t0 += 32) {
                bf16x8 kb[4][2];
#pragma unroll
                for (int i = 0; i < 4; ++i) { const int tl = (t0 + 8 * i < ntile) ? t0 + 8 * i : t0; const bf16_t* kp = kbase + (size_t)(tl * 16) * 64; kb[i][0] = *(const bf16x8*)kp; kb[i][1] = *(const bf16x8*)(kp + 32); }
#pragma unroll
                for (int i = 0; i < 4; ++i) if (t0 + 8 * i < ntile) {
                    const int key0 = (t0 + 8 * i) * 16;
                    float sc[4] = {0.f, 0.f, 0.f, 0.f};
#pragma unroll
                    for (int h = 0; h < 4; ++h) { f32x4 a = {0.f, 0.f, 0.f, 0.f}; a = MFMA16(qa[h][0], kb[i][0], a); a = MFMA16(qa[h][1], kb[i][1], a);
#pragma unroll
                        for (int r = 0; r < 4; ++r) sc[r] += wq[r][h] * fmaxf(a[r], 0.f); }
#pragma unroll
                    for (int r = 0; r < 4; ++r) { float sv = sc[r]; if (sv == 0.f) sv = 0.f; const int key = key0 + l15, e = key >> 6;
                        scr[(size_t)(quad * 4 + r) * 8192 + (e >> 2) * 256 + (key & 63) * 4 + (e & 3)] = sv; }
                }
            }
        }
        __syncthreads();
        for (int qi = 0; qi < 2; ++qi) {
            const int qq = wave * 2 + qi; const float* sbase = scr + (size_t)qq * 8192;
            unsigned kv[128];
            { int ne = nkeys >> 6; asm volatile("" : "+s"(ne));
#pragma unroll
            for (int g = 0; g < 4; ++g) {
                if (32 * g < ne) {
                    f32x4 tv[8];
#pragma unroll
                    for (int i = 0; i < 8; ++i) tv[i] = ld4(sbase + (8 * g + i) * 256 + lane * 4);
#pragma unroll
                    for (int i = 0; i < 8; ++i)
#pragma unroll
                        for (int j = 0; j < 4; ++j) { const int e = 32 * g + 4 * i + j; kv[e] = (e < ne) ? (fkey(tv[i][j]) & 0xffff0000u) : 0u; }
                } else {
#pragma unroll
                    for (int i = 0; i < 32; ++i) kv[32 * g + i] = 0u;
                }
                __builtin_amdgcn_sched_barrier(0);
            } }
            unsigned prefix = 0u, pmask = 0u; int krem = 256;
#pragma nounroll
            for (int pass = 0; pass < 4; ++pass) {
                const int shift = 28 - 4 * pass;
                int ne = nkeys >> 6; asm volatile("" : "+s"(ne));
                { const unsigned z = ozero();
#pragma unroll
                  for (int b = 0; b < 16; ++b) hist[b * 64 + lane] = z; }
#pragma unroll
                for (int g = 0; g < 8; ++g) if (16 * g < ne) {
#pragma unroll
                    for (int i = 0; i < 16; ++i) { const unsigned k = kv[16 * g + i];
                        __hip_atomic_fetch_add(&hist[((k >> shift) & 15u) * 64 + lane], ((k & pmask) == prefix) ? 1u : 0u, __ATOMIC_RELAXED, __HIP_MEMORY_SCOPE_WORKGROUP); } }
                int sum = 0;
                { const LAS u32x4* hp = (const LAS u32x4*)(hist + (lane & 15) * 64 + (lane >> 4) * 16);
#pragma unroll
                  for (int i = 0; i < 4; ++i) { const u32x4 v = hp[i]; sum += (int)(v.x + v.y + v.z + v.w); } }
                sum += __shfl_xor(sum, 16); sum += __shfl_xor(sum, 32);
                int incl = sum;
#pragma unroll
                for (int o = 1; o < 16; o <<= 1) { const int tt = __shfl_down(incl, o); if ((lane & 15) + o < 16) incl += tt; }
                const int excl = incl - sum;
                const bool hit = (lane < 16) && (excl < krem) && (krem <= incl);
                const u64 bal = __ballot(hit); const int src = bal ? (int)__builtin_ctzll(bal) : 0;
                const int ex = __shfl(excl, src);
                prefix |= ((unsigned)src) << shift; pmask |= 15u << shift; krem -= ex;
            }
            int run = 0, zcut = nkeys - 1; bool found = false;
            int ne = nkeys >> 6; asm volatile("" : "+s"(ne));
#pragma unroll
            for (int e = 0; e < 128; ++e) if (e < ne) {
                const bool eq = kv[e] == prefix; const u64 bal = __ballot(eq); const int cnt = __builtin_popcountll(bal);
                if (!found && run + cnt >= krem) { const int need = krem - run; const int below = (int)__builtin_amdgcn_mbcnt_hi((unsigned)(bal >> 32), __builtin_amdgcn_mbcnt_lo((unsigned)bal, 0u)) + 1;
                    const bool me = eq && (below == need); const u64 b2 = __ballot(me); zcut = e * 64 + (b2 ? (int)__builtin_ctzll(b2) : 63); found = true; }
                run += cnt;
                __builtin_amdgcn_sched_barrier(0);
            }
            asm volatile("" : "+s"(ne));
            const int zc = __builtin_amdgcn_readfirstlane(zcut), zw = zc >> 6, zb = zc & 63;
#pragma unroll
            for (int e = 0; e < 128; ++e) if (e < ne) { const unsigned k = kv[e]; const bool tie_ok = (e < zw) ? true : ((e == zw) ? (lane <= zb) : false); const bool sel = (k > prefix) || (k == prefix && tie_ok);
                const u64 bal = __ballot(sel); if (lane == 0) MASK[(size_t)(row0 + qq) * 128 + e] = bal; __builtin_amdgcn_sched_barrier(0); }
        }
        __syncthreads();
    }
}

__device__ __forceinline__ void phase_dsa_attn(LAS unsigned char* lds, const bf16_t* PD, const bf16_t* Kc, const bf16_t* Vc, const u64* MASK, bf16_t* YC, int tid) {
    const int wave = __builtin_amdgcn_readfirstlane(tid >> 6), lane = tid & 63, l15 = lane & 15, quad = lane >> 4;
    const int G = gridDim.x, bid = blockIdx.x;
    const int kp = tid >> 3, sseg = tid & 7;
    for (int it = 0;; ++it) {
        const int uo = it * G + ((it & 1) ? (G - 1 - bid) : bid);
        if (uo >= 2048) break;
        const int qb = 63 - (uo >> 5), bh = uo & 31, b = bh >> 3, head = bh & 7;
        const int row0 = b * 8192 + qb * 128 + wave * 16, nst = qb + 1, qchunk = 2 * qb + (wave >> 2);
        bf16x8 qf[2];
#pragma unroll
        for (int ks = 0; ks < 2; ++ks) { float qv[8]; unpack8(*(const u32x4*)(PD + (size_t)(row0 + l15) * PD_LD + head * 64 + ks * 32 + quad * 8), qv);
#pragma unroll
            for (int j = 0; j < 8; ++j) qv[j] *= 0.18033688011112042f;
            qf[ks] = pack8(qv); }
        float mrun = -1e30f, lrun = 0.f; f32x4 o[4];
#pragma unroll
        for (int dt = 0; dt < 4; ++dt) o[dt] = (f32x4){0.f, 0.f, 0.f, 0.f};
        const size_t kvo = ((size_t)((b * 8 + head) * 8192) + 2 * kp) * 64 + sseg * 8;
        const bf16_t* kcp = Kc + kvo; const bf16_t* vcp = Vc + kvo;
        u32x4 kreg0 = *(const u32x4*)kcp, vreg0 = *(const u32x4*)vcp, kreg1 = *(const u32x4*)(kcp + 64), vreg1 = *(const u32x4*)(vcp + 64);
        const u64* mrow = MASK + (size_t)(row0 + l15) * 128;
        u64 mn0 = mrow[0], mn1 = (1 <= qchunk) ? mrow[1] : 0ull;
        __syncthreads();
            { LAS bf16_t* Ks = (LAS bf16_t*)lds + (0) * 17920; LAS bf16_t* Vt = Ks + 128 * 72;
            *(LAS u32x4*)(Ks + (2 * kp) * 72 + sseg * 8) = kreg0; *(LAS u32x4*)(Ks + (2 * kp + 1) * 72 + sseg * 8) = kreg1;
            { const unsigned va[4] = {vreg0.x, vreg0.y, vreg0.z, vreg0.w}, vb[4] = {vreg1.x, vreg1.y, vreg1.z, vreg1.w};
              LAS unsigned* vtw = (LAS unsigned*)Vt + (sseg * 8) * 68 + (kp ^ (((sseg >> 1) & 3) << 3));
#pragma unroll
              for (int e = 0; e < 4; ++e) { vtw[(2 * e) * 68] = (va[e] & 0xffffu) | (vb[e] << 16); vtw[(2 * e + 1) * 68] = (va[e] >> 16) | (vb[e] & 0xffff0000u); } }
            }
        __syncthreads();
        for (int st = 0; st < nst; ++st) {
            const LAS bf16_t* Ks = (const LAS bf16_t*)lds + (st & 1) * 17920; const LAS bf16_t* Vt = Ks + 128 * 72;
            const u64 mw0 = mn0, mw1 = mn1;
            if (st + 1 < nst) { const size_t no = (size_t)(st + 1) * 128 * 64; kreg0 = *(const u32x4*)(kcp + no); vreg0 = *(const u32x4*)(vcp + no); kreg1 = *(const u32x4*)(kcp + no + 64); vreg1 = *(const u32x4*)(vcp + no + 64);
                mn0 = mrow[2 * st + 2]; mn1 = (2 * st + 3 <= qchunk) ? mrow[2 * st + 3] : 0ull; }
            f32x4 acc[8];
#pragma unroll
            for (int mt = 0; mt < 8; ++mt) { acc[mt] = (f32x4){0.f, 0.f, 0.f, 0.f};
#pragma unroll
                for (int ks = 0; ks < 2; ++ks) { const bf16x8 a = *(const LAS bf16x8*)(Ks + (16 * mt + l15) * 72 + ks * 32 + quad * 8); acc[mt] = MFMA16(a, qf[ks], acc[mt]); } }
            const unsigned mb[4] = {(unsigned)(mw0 >> (4 * quad)), (unsigned)(mw0 >> (32 + 4 * quad)), (unsigned)(mw1 >> (4 * quad)), (unsigned)(mw1 >> (32 + 4 * quad))};
            float tmax = -1e30f;
#pragma unroll
            for (int mt = 0; mt < 8; ++mt)
#pragma unroll
                for (int r = 0; r < 4; ++r) { const bool sel = ((mb[mt >> 1] >> (16 * (mt & 1) + r)) & 1u) != 0u; acc[mt][r] = sel ? acc[mt][r] : -1e30f; tmax = fmaxf(tmax, acc[mt][r]); }
            tmax = fmaxf(tmax, __shfl_xor(tmax, 16)); tmax = fmaxf(tmax, __shfl_xor(tmax, 32));
            const float mnew = fmaxf(mrun, tmax), alpha = __builtin_amdgcn_exp2f(mrun - mnew), meff = fmaxf(mnew, -1e29f);
            float psum = 0.f;
#pragma unroll
            for (int mt = 0; mt < 8; ++mt)
#pragma unroll
                for (int r = 0; r < 4; ++r) { const float p = __builtin_amdgcn_exp2f(acc[mt][r] - meff); acc[mt][r] = p; psum += p; }
            lrun = lrun * alpha + psum; mrun = mnew;
            bf16x8 pb[4];
#pragma unroll
            for (int k2 = 0; k2 < 4; ++k2) { u32x4 w; w.x = pg8::cvt_pk_bf16(acc[2 * k2][0], acc[2 * k2][1]); w.y = pg8::cvt_pk_bf16(acc[2 * k2][2], acc[2 * k2][3]); w.z = pg8::cvt_pk_bf16(acc[2 * k2 + 1][0], acc[2 * k2 + 1][1]); w.w = pg8::cvt_pk_bf16(acc[2 * k2 + 1][2], acc[2 * k2 + 1][3]);
                pb[k2] = __builtin_bit_cast(bf16x8, w); }
#pragma unroll
            for (int dt = 0; dt < 4; ++dt) { o[dt] = o[dt] * alpha;
#pragma unroll
                for (int k2 = 0; k2 < 4; ++k2) { const LAS unsigned* vr = (const LAS unsigned*)Vt + l15 * 68 + 2 * quad;
                    const u32x2 lo = *(const LAS u32x2*)(vr + 16 * dt * 68 + ((16 * k2) ^ (dt << 3))), hi = *(const LAS u32x2*)(vr + 16 * dt * 68 + ((16 * k2 + 8) ^ (dt << 3)));
                    u32x4 w; w.x = lo.x; w.y = lo.y; w.z = hi.x; w.w = hi.y;
                    o[dt] = MFMA16(__builtin_bit_cast(bf16x8, w), pb[k2], o[dt]); } }
            if (st + 1 < nst) {
                { LAS bf16_t* Ks = (LAS bf16_t*)lds + ((st + 1) & 1) * 17920; LAS bf16_t* Vt = Ks + 128 * 72;
                *(LAS u32x4*)(Ks + (2 * kp) * 72 + sseg * 8) = kreg0; *(LAS u32x4*)(Ks + (2 * kp + 1) * 72 + sseg * 8) = kreg1;
                { const unsigned va[4] = {vreg0.x, vreg0.y, vreg0.z, vreg0.w}, vb[4] = {vreg1.x, vreg1.y, vreg1.z, vreg1.w};
                  LAS unsigned* vtw = (LAS unsigned*)Vt + (sseg * 8) * 68 + (kp ^ (((sseg >> 1) & 3) << 3));
#pragma unroll
                  for (int e = 0; e < 4; ++e) { vtw[(2 * e) * 68] = (va[e] & 0xffffu) | (vb[e] << 16); vtw[(2 * e + 1) * 68] = (va[e] >> 16) | (vb[e] & 0xffff0000u); } }
                }
            }
            __syncthreads();
        }
        lrun += __shfl_xor(lrun, 16); lrun += __shfl_xor(lrun, 32);
        const float il = 1.f / lrun;
#pragma unroll
        for (int dt = 0; dt < 4; ++dt) { u32x2 w; w.x = pk2(o[dt][0] * il, o[dt][1] * il); w.y = pk2(o[dt][2] * il, o[dt][3] * il);
            *(u32x2*)(YC + (size_t)(row0 + l15) * 1024 + 512 + head * 64 + 16 * dt + 4 * quad) = w; }
    }
}

struct RwPar { const float *mu, *w0, *a0, *k_k, *k_a, *r_k, *gn_g, *gn_b; };

__device__ __forceinline__ void phase_rw_prep(const bf16_t* PR, const bf16_t* SM, const RwPar rp, bf16_t* E, bf16_t* A, bf16_t* Gt, int tid) {
    const int wave = __builtin_amdgcn_readfirstlane(tid >> 6), lane = tid & 63, l15 = lane & 15, quad = lane >> 4;
    const bf16_t* W2T = SM; const bf16_t* A2T = SM + 32768; const bf16_t* G2T = SM + 65536;
    for (int uid = blockIdx.x * 8 + wave; uid < 2048; uid += gridDim.x * 8) {
        const int row = uid * 16 + l15; const bool hasprev = (row & 8191) != 0;
        bf16x8 fw[2], fa[2], fg[4];
#pragma unroll
        for (int ks = 0; ks < 8; ++ks) {
            const int c0 = 1536 + ks * 32 + quad * 8; float p[8], q[8];
            unpack8(*(const u32x4*)(PR + (size_t)row * PR_LD + c0), p);
            if (hasprev) unpack8(*(const u32x4*)(PR + (size_t)(row - 1) * PR_LD + c0), q); else {
#pragma unroll
                for (int j = 0; j < 8; ++j) q[j] = 0.f; }
#pragma unroll
            for (int j = 0; j < 8; ++j) { float v = p[j] + (q[j] - p[j]) * rp.mu[c0 + j];
                if (ks < 2) { const float e2 = __expf(-2.f * fabsf(v)); const float th = (1.f - e2) / (1.f + e2); v = v < 0.f ? -th : th; } else if (ks >= 4) v = 1.f / (1.f + __expf(-v));
                p[j] = v; }
            const bf16x8 fr = pack8(p);
            if (ks < 2) fw[ks] = fr; else if (ks < 4) fa[ks - 2] = fr; else fg[ks - 4] = fr;
        }
        for (int nt = 0; nt < 32; ++nt) {
            const int cw = 16 * nt + l15;
            f32x4 aw = {0.f, 0.f, 0.f, 0.f}, aa = aw, ag = aw;
#pragma unroll
            for (int ks = 0; ks < 2; ++ks) { aw = MFMA16(*(const bf16x8*)(W2T + cw * 64 + ks * 32 + quad * 8), fw[ks], aw); aa = MFMA16(*(const bf16x8*)(A2T + cw * 64 + ks * 32 + quad * 8), fa[ks], aa); }
#pragma unroll
            for (int ks = 0; ks < 4; ++ks) ag = MFMA16(*(const bf16x8*)(G2T + cw * 128 + ks * 32 + quad * 8), fg[ks], ag);
            const int c = 16 * nt + 4 * quad; float e[4], a[4];
#pragma unroll
            for (int r = 0; r < 4; ++r) { const float lw = rp.w0[c + r] + aw[r]; const float x = -lw;
                const float sp = fmaxf(x, 0.f) + __logf(1.f + __expf(-fabsf(x)));
                e[r] = __expf(-sp - 0.5f); a[r] = 1.f / (1.f + __expf(-(rp.a0[c + r] + aa[r]))); }
            const size_t o = (size_t)row * 512 + c;
            u32x2 w; w.x = pk2(e[0], e[1]); w.y = pk2(e[2], e[3]); *(u32x2*)(E + o) = w;
            w.x = pk2(a[0], a[1]); w.y = pk2(a[2], a[3]); *(u32x2*)(A + o) = w;
            w.x = pk2(ag[0], ag[1]); w.y = pk2(ag[2], ag[3]); *(u32x2*)(Gt + o) = w;
        }
    }
}

__device__ __forceinline__ void phase_rw_scan(LAS unsigned char* lds, const bf16_t* PR, const bf16_t* E, const bf16_t* A, const RwPar rp, bf16_t* QP, bf16_t* OU, float* PU, int tid) {
    const int wave = __builtin_amdgcn_readfirstlane(tid >> 6), lane = tid & 63, pairi = wave >> 1, wsub = wave & 1, half = lane >> 5, ri = lane & 31;
    LAS float* vec = (LAS float*)lds + pairi * 3104;
    LAS float* vv = vec + 2560; LAS float* cs = vv + 512;
    const int irow = 32 * wsub + ri;
    for (int uid = blockIdx.x * 4 + pairi; uid < 1024; uid += gridDim.x * 4) {
        const int chunk = uid & 31, bh = uid >> 5, h = bh & 7, b = bh >> 3;
        const int col = h * 64 + lane;
        const float mur = rp.mu[col], muk = rp.mu[512 + col], muv = rp.mu[1024 + col], kk_ = rp.k_k[col], ka_ = rp.k_a[col];
        float SU[32], SP[32];
        int dsel = irow - 32 * half; asm volatile("" : "+v"(dsel));
#pragma unroll
        for (int j = 0; j < 32; ++j) { SU[j] = 0.f; SP[j] = (j == dsel) ? 1.f : 0.f; }
        const int tbase = chunk * 256;
        unsigned raw[4][4];
#define RW_LOAD_RAW(SUB) do { _Pragma("unroll") for (int s4 = 0; s4 < 4; ++s4) { const int t = tbase + (SUB) * 8 + 4 * wsub + s4; const size_t row = (size_t)b * 8192 + t; \
            const bf16_t* pr = PR + row * PR_LD + col; const bf16_t* pq = (t > 0) ? pr - PR_LD : pr; const unsigned pm = (t > 0) ? 0xffffffffu : 0x0000ffffu; \
            raw[s4][0] = ((unsigned)pr[0] | ((unsigned)pq[0] << 16)) & pm; raw[s4][1] = ((unsigned)pr[512] | ((unsigned)pq[512] << 16)) & pm; raw[s4][2] = ((unsigned)pr[1024] | ((unsigned)pq[1024] << 16)) & pm; \
            raw[s4][3] = (unsigned)E[row * 512 + col] | ((unsigned)A[row * 512 + col] << 16); } } while (0)
        RW_LOAD_RAW(0);
#pragma nounroll
        for (int sub = 0; sub < 32; ++sub) {
            __syncthreads();
#pragma unroll
            for (int s4 = 0; s4 < 4; ++s4) {
                const int s = 4 * wsub + s4;
                float r = bf2f(raw[s4][0] & 0xffffu), k = bf2f(raw[s4][1] & 0xffffu), v = bf2f(raw[s4][2] & 0xffffu);
                const float rq = bf2f(raw[s4][0] >> 16), kq = bf2f(raw[s4][1] >> 16), vq = bf2f(raw[s4][2] >> 16);
                r += (rq - r) * mur; k += (kq - k) * muk; v += (vq - v) * muv;
                const float e = bf2f(raw[s4][3] & 0xffffu), a = bf2f(raw[s4][3] >> 16);
                const float w = __expf(-e);
                const float kr = k * kk_; const float kp = k * (1.f + (a - 1.f) * ka_);
                const float n2 = wave_sum(kr * kr), c1r = wave_sum(kr * a * r), c2 = wave_sum(kp * r);
                const float inrm = 1.f / fmaxf(sqrtf(n2), 1e-12f);
                const float kn = kr * inrm, kka = kn * a, c1 = c1r * inrm;
                LAS float* vs = vec + s * 320;
                vs[lane] = -kn; vs[64 + lane] = w * r; vs[128 + lane] = w; vs[192 + lane] = kka; vs[256 + lane] = kp;
                vv[s * 64 + lane] = v;
                if (lane == 0) { cs[2 * s] = c1; cs[2 * s + 1] = c2; }
            }
            __syncthreads();
            if (sub + 1 < 32) RW_LOAD_RAW(sub + 1);
#pragma nounroll
            for (int s = 0; s < 8; ++s) {
                const LAS float* vs = vec + s * 320 + 32 * half;
                float saU = 0.f, saP = 0.f, oU = 0.f, oP = 0.f;
#pragma unroll
                for (int j4 = 0; j4 < 8; ++j4) { const f32x4 nk = *(const LAS f32x4*)(vs + 4 * j4), wr = *(const LAS f32x4*)(vs + 64 + 4 * j4);
#pragma unroll
                    for (int q = 0; q < 4; ++q) { const int j = 4 * j4 + q; saU += SU[j] * nk[q]; saP += SP[j] * nk[q]; oU += SU[j] * wr[q]; oP += SP[j] * wr[q]; }
                    __builtin_amdgcn_sched_barrier(0); }
                saU += __shfl_xor(saU, 32); saP += __shfl_xor(saP, 32); oU += __shfl_xor(oU, 32); oP += __shfl_xor(oP, 32);
                const float vi = vv[s * 64 + irow], c1 = cs[2 * s], c2 = cs[2 * s + 1];
#pragma unroll
                for (int j4 = 0; j4 < 8; ++j4) { const f32x4 w4 = *(const LAS f32x4*)(vs + 128 + 4 * j4), ka4 = *(const LAS f32x4*)(vs + 192 + 4 * j4), kp4 = *(const LAS f32x4*)(vs + 256 + 4 * j4);
#pragma unroll
                    for (int q = 0; q < 4; ++q) { const int j = 4 * j4 + q; SU[j] = SU[j] * w4[q] + saU * ka4[q] + vi * kp4[q]; SP[j] = SP[j] * w4[q] + saP * ka4[q]; }
                    __builtin_amdgcn_sched_barrier(0); }
                const size_t o = ((size_t)b * 8192 + tbase + sub * 8 + s) * 512 + h * 64 + irow;
                if (half == 0) OU[o] = (bf16_t)f2bf(oU + saU * c1 + vi * c2);
                else QP[o] = (bf16_t)f2bf(oP + saP * c1);
            }
        }
#undef RW_LOAD_RAW
        float* pu = PU + (size_t)uid * 8192 + irow * 64 + 32 * half;
#pragma unroll
        for (int j4 = 0; j4 < 8; ++j4) { *(f32x4*)(pu + 4 * j4) = (f32x4){SP[4 * j4], SP[4 * j4 + 1], SP[4 * j4 + 2], SP[4 * j4 + 3]};
            *(f32x4*)(pu + 4096 + 4 * j4) = (f32x4){SU[4 * j4], SU[4 * j4 + 1], SU[4 * j4 + 2], SU[4 * j4 + 3]}; }
    }
}

__device__ __forceinline__ void phase_rw_combine(LAS unsigned char* lds, const float* PU, float* SINIT, int tid) {
    const int wave = __builtin_amdgcn_readfirstlane(tid >> 6), lane = tid & 63;
    LAS float* sl = (LAS float*)lds + wave * 512;
    LAS float* Pl = (LAS float*)lds + 4096;
    for (int bh = blockIdx.x; bh < 32; bh += gridDim.x) {
        float s[8], un[8];
#pragma unroll
        for (int r = 0; r < 8; ++r) s[r] = 0.f;
        const float* P0 = PU + (size_t)(bh * 32) * 8192;
        f32x4 r0 = ld4(P0 + 4 * tid), r1 = ld4(P0 + 2048 + 4 * tid);
#pragma unroll
        for (int r = 0; r < 8; ++r) un[r] = P0[4096 + (wave * 8 + r) * 64 + lane];
        __syncthreads();
        *(LAS f32x4*)(Pl + 4 * tid) = r0; *(LAS f32x4*)(Pl + 2048 + 4 * tid) = r1;
        __syncthreads();
#pragma nounroll
        for (int c = 0; c < 32; ++c) {
            const int uid = bh * 32 + c;
            const LAS float* Pc = Pl + (c & 1) * 4096;
            float acc[8];
#pragma unroll
            for (int r = 0; r < 8; ++r) { SINIT[(size_t)uid * 4096 + (wave * 8 + r) * 64 + lane] = s[r]; sl[r * 64 + lane] = s[r]; acc[r] = un[r]; }
            const int cn = (c + 1 < 32) ? c + 1 : c;
            const float* Pn = PU + (size_t)(bh * 32 + cn) * 8192;
            r0 = ld4(Pn + 4 * tid); r1 = ld4(Pn + 2048 + 4 * tid);
#pragma unroll
            for (int r = 0; r < 8; ++r) un[r] = Pn[4096 + (wave * 8 + r) * 64 + lane];
            __builtin_amdgcn_wave_barrier();
#pragma unroll 4
            for (int j4 = 0; j4 < 16; ++j4) {
                const float p0 = Pc[(4 * j4) * 64 + lane], p1 = Pc[(4 * j4 + 1) * 64 + lane], p2 = Pc[(4 * j4 + 2) * 64 + lane], p3 = Pc[(4 * j4 + 3) * 64 + lane];
#pragma unroll
                for (int r = 0; r < 8; ++r) { const f32x4 sv = *(const LAS f32x4*)(sl + r * 64 + 4 * j4); acc[r] += sv[0] * p0 + sv[1] * p1 + sv[2] * p2 + sv[3] * p3; }
            }
#pragma unroll
            for (int r = 0; r < 8; ++r) s[r] = acc[r];
            LAS float* Pw = Pl + ((c + 1) & 1) * 4096;
            *(LAS f32x4*)(Pw + 4 * tid) = r0; *(LAS f32x4*)(Pw + 2048 + 4 * tid) = r1;
            __syncthreads();
        }
    }
}

__device__ __forceinline__ void phase_rw_out(LAS unsigned char* lds, const bf16_t* PR, const bf16_t* A, const bf16_t* Gt, const bf16_t* QP, const bf16_t* OU, const float* SINIT, const RwPar rp, bf16_t* YC, int tid) {
    const int wave = __builtin_amdgcn_readfirstlane(tid >> 6), lane = tid & 63;
    LAS float* qs = (LAS float*)lds + wave * 1024;
    for (int uid = blockIdx.x * 8 + wave; uid < 2048; uid += gridDim.x * 8) {
        const int chunk = uid & 63, bh = uid >> 6, h = bh & 7, b = bh >> 3;
        const int col = h * 64 + lane;
        const float mur = rp.mu[col], muk = rp.mu[512 + col], muv = rp.mu[1024 + col], ka_ = rp.k_a[col], rk_ = rp.r_k[col], gg = rp.gn_g[col], gb = rp.gn_b[col];
        float S[64];
        const float* sp = SINIT + (size_t)(bh * 32 + (chunk >> 1)) * 4096 + lane * 64;
#pragma unroll
        for (int j4 = 0; j4 < 16; ++j4) { const f32x4 v = ld4(sp + 4 * j4); S[4 * j4] = v[0]; S[4 * j4 + 1] = v[1]; S[4 * j4 + 2] = v[2]; S[4 * j4 + 3] = v[3]; }
        for (int sub = 0; sub < 8; ++sub) {
            const size_t rbase = (size_t)b * 8192 + chunk * 128 + sub * 16;
#pragma unroll
            for (int s = 0; s < 16; ++s) qs[s * 64 + lane] = bf2f(QP[(rbase + s) * 512 + col]);
            __builtin_amdgcn_wave_barrier();
#pragma unroll 4
            for (int s = 0; s < 16; ++s) {
                const size_t row = rbase + s; const int t = (int)(row & 8191);
                float o = bf2f(OU[row * 512 + col]);
#pragma unroll
                for (int j4 = 0; j4 < 16; ++j4) { const f32x4 q = *(const LAS f32x4*)(qs + s * 64 + 4 * j4); o += S[4 * j4] * q[0] + S[4 * j4 + 1] * q[1] + S[4 * j4 + 2] * q[2] + S[4 * j4 + 3] * q[3]; }
                const bf16_t* pr = PR + row * PR_LD + col;
                float r = bf2f(pr[0]), k = bf2f(pr[512]), v = bf2f(pr[1024]);
                float rq = 0.f, kq = 0.f, vq = 0.f;
                if (t > 0) { rq = bf2f(pr[-PR_LD]); kq = bf2f(pr[512 - PR_LD]); vq = bf2f(pr[1024 - PR_LD]); }
                r += (rq - r) * mur; k += (kq - k) * muk; v += (vq - v) * muv;
                const float a = bf2f(A[row * 512 + col]);
                const float kp = k * (1.f + (a - 1.f) * ka_);
                const float s1 = wave_sum(o), s2 = wave_sum(o * o), bsum = wave_sum(r * kp * rk_);
                const float mean = s1 * (1.f / 64.f), d = o - mean, var = fmaxf(s2 * (1.f / 64.f) - mean * mean, 0.f);
                const float on = d * (1.f / sqrtf(var + GN_EPS)) * gg + gb;
                const float g = bf2f(Gt[row * 512 + col]);
                YC[row * 1024 + col] = (bf16_t)f2bf((on + bsum * v) * g);
            }
            __builtin_amdgcn_wave_barrier();
        }
    }
}

struct Args { const float* in[33]; float* out; unsigned char* ws; int ph_lo, ph_hi; };
enum { P_MOD = 0, P_CVT0, P_GIN_E, P_DPREP, P_DSEL, P_DATTN, P_RPREP, P_RSCAN, P_RCOMB, P_ROUT, P_GIN_O, P_ODDMIX, P_GOUT, P_LN1, P_GUP, P_FIX, P_GDN, P_LN2, P_COUNT };

template <int P, bool TAB>
__device__ __forceinline__ void run_phase(const Args& args, LAS unsigned char* lds, const int l, const int wv) {
#define otid() otid_(wv)
#define TABP(k) ({ unsigned a_ = TAB_OFF + 8 * (k); asm volatile("" : "+s"(a_)); const u64 v_ = *(volatile LAS u64*)(lds + a_); const unsigned lo_ = __builtin_amdgcn_readfirstlane((unsigned)v_), hi_ = __builtin_amdgcn_readfirstlane((unsigned)(v_ >> 32)); (((u64)hi_) << 32) | lo_; })
#define IN(k) (TAB ? (const float*)TABP(k) : args.in[k])
#define ws (TAB ? (unsigned char*)TABP(34) : args.ws)
#define X (TAB ? (float*)TABP(33) : args.out)
#define MOD ((float*)(ws + WS_MOD))
#define H ((bf16_t*)(ws + WS_H))
#define YC ((bf16_t*)(ws + WS_YC))
#define PR ((bf16_t*)(ws + WS_PR))
#define PD ((bf16_t*)(ws + WS_PD))
#define WIN ((bf16_t*)(ws + WS_WIN))
#define WOUT ((bf16_t*)(ws + WS_WOUT))
#define WUP ((bf16_t*)(ws + WS_WUP))
#define WDN ((bf16_t*)(ws + WS_WDN))
#define SM ((bf16_t*)(ws + WS_SMALL))
#define HID ((bf16_t*)(ws + WS_HID))
#define SIDE ((float*)(ws + WS_SIDE))
#define x_in IN(0)
#define CVT_PTRS(l) CvtPtrs{ ((l) & 1) ? IN(25) + (size_t)((l) >> 1) * 1024 * ODD_COLS : IN(10) + (size_t)((l) >> 1) * 1024 * EVEN_COLS, \
                             ((l) & 1) ? IN(26) + (size_t)((l) >> 1) * 1048576 : IN(11) + (size_t)((l) >> 1) * 1048576, \
                             IN(6) + (size_t)(l) * 1024 * 5632, IN(9) + (size_t)(l) * 2816 * 1024, \
                             ((l) & 1) ? IN(27) + (size_t)((l) >> 1) * 65536 : IN(14) + (size_t)((l) >> 1) * 32768, \
                             ((l) & 1) ? IN(31) + (size_t)((l) >> 1) * 65536 : IN(16) + (size_t)((l) >> 1) * 32768, \
                             ((l) & 1) ? nullptr : IN(17) + (size_t)((l) >> 1) * 65536 }
#define modl (MOD + (size_t)l * 4 * 6144)
#define xsrc ((l == 0) ? x_in : X)
#define rp (RwPar{IN(12) + e * 1792, IN(13) + e * 512, IN(15) + e * 512, IN(18) + e * 512, IN(19) + e * 512, IN(20) + e * 512, IN(21) + e * 512, IN(22) + e * 512})
#define Eb ((bf16_t*)(ws + WS_E))
#define Ab ((bf16_t*)(ws + WS_A))
#define Gb ((bf16_t*)(ws + WS_G))
#define QP ((bf16_t*)(ws + WS_QP))
#define OU ((bf16_t*)(ws + WS_OU))
#define PU ((float*)(ws + WS_PU))
#define SI ((float*)(ws + WS_SINIT))
    const int e = l >> 1;
    if constexpr (P == P_MOD) phase_mod(lds, IN(1), IN(2), IN(3), MOD, otid());
    if constexpr (P == P_CVT0) { phase_convert(lds, ws, CVT_PTRS(0), true, otid()); phase_h0(x_in, MOD, H, otid()); phase_rope_table((float*)(ws + WS_ROPE), otid()); }
    if constexpr (P == P_GIN_E) { pg8::Gemm g{H, WIN, M, EVEN_PAD, D}; pg8::StaticOrder S; S.init(M, EVEN_PAD, gridDim.x, blockIdx.x);
        pg8::EpiStoreP E{PR, PR_LD, 7, PD, PD_LD};
        pg8::gemm_phase<pg8::EpiStoreP, pg8::StaticOrder, true, true>(lds, g, S, E, otid()); }
    if constexpr (P == P_DPREP) phase_dsa_prep(PD, IN(23) + e * 64, IN(24) + e * 64, (const float*)(ws + WS_ROPE), (bf16_t*)(ws + WS_KC), (bf16_t*)(ws + WS_VC), (bf16_t*)(ws + WS_KI), otid());
    if constexpr (P == P_DSEL) { float* scr = (float*)(ws + ((blockIdx.x < 128) ? WS_SCRA + (size_t)blockIdx.x * 524288 : WS_SCRB + (size_t)(blockIdx.x - 128) * 524288));
        phase_dsa_select(lds, PD, (const bf16_t*)(ws + WS_KI), scr, (u64*)(ws + WS_MASK), otid()); }
    if constexpr (P == P_DATTN) phase_dsa_attn(lds, PD, (const bf16_t*)(ws + WS_KC), (const bf16_t*)(ws + WS_VC), (const u64*)(ws + WS_MASK), YC, otid());
    if constexpr (P == P_RPREP) phase_rw_prep(PR, SM, rp, Eb, Ab, Gb, otid());
    if constexpr (P == P_RSCAN) phase_rw_scan(lds, PR, Eb, Ab, rp, QP, OU, PU, otid());
    if constexpr (P == P_RCOMB) phase_rw_combine(lds, PU, SI, otid());
    if constexpr (P == P_ROUT) phase_rw_out(lds, PR, Ab, Gb, QP, OU, SI, rp, YC, otid());
    if constexpr (P == P_GIN_O) { pg8::Gemm g{H, WIN, M, ODD_COLS, D}; pg8::StaticOrder S; S.init(M, ODD_COLS, gridDim.x, blockIdx.x);
        pg8::EpiStoreP E{PR, ODD_COLS, 6, PR, ODD_COLS};
        pg8::gemm_phase<pg8::EpiStoreP, pg8::StaticOrder, true, true>(lds, g, S, E, otid()); }
    if constexpr (P == P_ODDMIX) { phase_pool(PR, SM + 131072, IN(28) + e * 512, YC, otid());
        phase_sgu(lds, PR, SM + 196608, IN(29) + e * 512, IN(30) + e * 512, IN(32) + e * 512, YC, otid()); }
    if constexpr (P == P_GOUT) { pg8::Gemm g{YC, WOUT, M, D, D}; pg8::StaticOrder S; S.init(M, D, gridDim.x, blockIdx.x);
        pg8::EpiResid E{xsrc, X, modl + 2 * 1024};
        pg8::gemm_phase<pg8::EpiResid, pg8::StaticOrder, true, true>(lds, g, S, E, otid()); }
    if constexpr (P == P_LN1) phase_ln(X, IN(4) + (size_t)(l * 2) * 1024, IN(5) + (size_t)(l * 2) * 1024, modl + 3 * 1024, H, otid());
    if constexpr (P == P_GUP) { pg8::Gemm g{H, WUP, M, DFF2, D}; pg8::StaticOrder S; S.init(M, DFF2, gridDim.x, blockIdx.x);
        pg8::EpiFFN E{HID, SIDE, IN(7) + (size_t)l * 3 * 5632, IN(8) + (size_t)l * 5632};
        pg8::gemm_phase<pg8::EpiFFN, pg8::StaticOrder, true, true>(lds, g, S, E, otid()); }
    if constexpr (P == P_FIX) phase_ffn_fix(SIDE, IN(7) + (size_t)l * 3 * 5632, IN(8) + (size_t)l * 5632, HID, otid());
    if constexpr (P == P_GDN) { pg8::Gemm g{HID, WDN, M, D, DFF}; pg8::StaticOrder S; S.init(M, D, gridDim.x, blockIdx.x);
        float* xx = X; pg8::EpiResid E{xx, xx, modl + 5 * 1024};
        pg8::gemm_phase<pg8::EpiResid, pg8::StaticOrder, true, true>(lds, g, S, E, otid()); }
    if constexpr (P == P_LN2) {
        phase_ln(X, IN(4) + (size_t)(l * 2 + 1) * 1024, IN(5) + (size_t)(l * 2 + 1) * 1024, (l < 3) ? (MOD + (size_t)(l + 1) * 4 * 6144) : nullptr, H, otid());
        if (l < 3) { if (l & 1) phase_convert(lds, ws, CVT_PTRS(l + 1), true, otid()); else phase_convert(lds, ws, CVT_PTRS(l + 1), false, otid()); }
    }
#undef otid
#undef TABP
#undef IN
#undef ws
#undef X
#undef MOD
#undef H
#undef YC
#undef PR
#undef PD
#undef WIN
#undef WOUT
#undef WUP
#undef WDN
#undef SM
#undef HID
#undef SIDE
#undef x_in
#undef CVT_PTRS
#undef modl
#undef xsrc
#undef rp
#undef Eb
#undef Ab
#undef Gb
#undef QP
#undef OU
#undef PU
#undef SI
}

template <int P>
__global__ void __launch_bounds__(NT, 2) phase_kernel(Args args, int l) {
    extern __shared__ __attribute__((aligned(16))) unsigned char lds_raw[];
    run_phase<P, false>(args, (LAS unsigned char*)lds_raw, l, __builtin_amdgcn_readfirstlane(threadIdx.x >> 6));
}

#ifndef MK_SINGLE
#define MK_SINGLE 1
#endif
#if MK_SINGLE
__global__ void __launch_bounds__(NT, 2) trunk_fwd(Args args) {
    extern __shared__ __attribute__((aligned(16))) unsigned char lds_raw[];
    LAS unsigned char* lds = (LAS unsigned char*)lds_raw;
    cg::grid_group grid = cg::this_grid();
    if (threadIdx.x < 33) ((LAS u64*)(lds + TAB_OFF))[threadIdx.x] = (u64)args.in[threadIdx.x];
    if (threadIdx.x == 33) ((LAS u64*)(lds + TAB_OFF))[33] = (u64)args.out;
    if (threadIdx.x == 34) ((LAS u64*)(lds + TAB_OFF))[34] = (u64)args.ws;
    if (threadIdx.x == 35) { ((LAS unsigned*)(lds + TAB_OFF + 512))[0] = 0u; ((LAS unsigned*)(lds + TAB_OFF + 512))[1] = 0u; }
    __syncthreads();
    const int wv = __builtin_amdgcn_readfirstlane(threadIdx.x >> 6);
#ifndef PROBE_MASK
#define PROBE_MASK 0
#endif
#define GSYNC() grid.sync()
#define PHASE(P, l) do { run_phase<P, true>(args, lds, (l), wv); GSYNC(); if ((PROBE_MASK >> P) & 1) { run_phase<P, true>(args, lds, (l), wv); GSYNC(); } } while (0)
    run_phase<P_MOD, true>(args, lds, 0, wv);
    grid.sync();
    PHASE(P_CVT0, 0);
#pragma nounroll
    for (int l = 0; l < 4; ++l) {
        if (!(l & 1)) { PHASE(P_GIN_E, l); PHASE(P_DPREP, l); PHASE(P_DSEL, l); PHASE(P_DATTN, l); PHASE(P_RPREP, l); PHASE(P_RSCAN, l); PHASE(P_RCOMB, l); PHASE(P_ROUT, l); }
        else { PHASE(P_GIN_O, l); PHASE(P_ODDMIX, l); }
        PHASE(P_GOUT, l); PHASE(P_LN1, l); PHASE(P_GUP, l); PHASE(P_FIX, l); PHASE(P_GDN, l);
        if (l < 3) PHASE(P_LN2, l); else run_phase<P_LN2, true>(args, lds, l, wv);
    }
#undef PHASE
#undef GSYNC
}
#endif
template <int P> static void launch_phase(const Args& a, int l, int grid, hipStream_t stream) {
    static bool attr_done = false;
    if (!attr_done) { (void)hipFuncSetAttribute((const void*)phase_kernel<P>, hipFuncAttributeMaxDynamicSharedMemorySize, LDS_BYTES); attr_done = true; }
    hipLaunchKernelGGL(phase_kernel<P>, dim3(grid), dim3(NT), LDS_BYTES, stream, a, l);
}

extern "C" void kernel_launch(void* const* d_in, const int* in_sizes, int n_in, void* d_out, int out_size, void* d_ws, size_t ws_size, hipStream_t stream) {
    static int grid = 0;
    if (grid == 0) {
        if (n_in != 33 || out_size != M * D || ws_size < WS_NEED) { fprintf(stderr, "kernel_launch: unexpected problem (n_in %d out %d ws %zu)\n", n_in, out_size, ws_size); grid = -1; return; }
        int dev = 0, cus = 0;
        (void)hipGetDevice(&dev); (void)hipDeviceGetAttribute(&cus, hipDeviceAttributeMultiprocessorCount, dev);
#if MK_SINGLE
        if (hipFuncSetAttribute((const void*)trunk_fwd, hipFuncAttributeMaxDynamicSharedMemorySize, LDS_BYTES) != hipSuccess) { fprintf(stderr, "kernel_launch: hipFuncSetAttribute failed\n"); grid = -1; return; }
#endif
        (void)hipGetLastError();
        grid = cus > 0 ? cus : 256;
    }
    if (grid < 0) return;
    Args a{};
    for (int i = 0; i < 33; ++i) a.in[i] = (const float*)d_in[i];
    a.out = (float*)d_out; a.ws = (unsigned char*)d_ws; a.ph_lo = 0; a.ph_hi = 1 << 20;
#if MK_SINGLE
    void* kargs[] = {&a};
    hipError_t er = hipLaunchCooperativeKernel((const void*)trunk_fwd, dim3(grid), dim3(NT), kargs, LDS_BYTES, stream);
    if (er != hipSuccess) fprintf(stderr, "kernel_launch: cooperative launch failed: %s\n", hipGetErrorString(er));
#else
    launch_phase<P_MOD>(a, 0, grid, stream); launch_phase<P_CVT0>(a, 0, grid, stream);
    for (int l = 0; l < 4; ++l) {
        if (!(l & 1)) { launch_phase<P_GIN_E>(a, l, grid, stream); launch_phase<P_DPREP>(a, l, grid, stream); launch_phase<P_DSEL>(a, l, grid, stream); launch_phase<P_DATTN>(a, l, grid, stream);
            launch_phase<P_RPREP>(a, l, grid, stream); launch_phase<P_RSCAN>(a, l, grid, stream); launch_phase<P_RCOMB>(a, l, grid, stream); launch_phase<P_ROUT>(a, l, grid, stream); }
        else { launch_phase<P_GIN_O>(a, l, grid, stream); launch_phase<P_ODDMIX>(a, l, grid, stream); }
        launch_phase<P_GOUT>(a, l, grid, stream); launch_phase<P_LN1>(a, l, grid, stream); launch_phase<P_GUP>(a, l, grid, stream); launch_phase<P_FIX>(a, l, grid, stream);
        launch_phase<P_GDN>(a, l, grid, stream); launch_phase<P_LN2>(a, l, grid, stream);
    }
#endif
}
```
